# Optimizing an MI355X kernel written in HIP

```python
import math
import jax
import jax.numpy as jnp
from jax import lax
import numpy as np

D_MODEL = 1024
BATCH = 2
SEQ = 8192
DEPTH = 2

PLE_DIM = 256
EPS = 1e-6

N_ATTN_HEADS = 8
N_BUCKETS = 32
MAX_DISTANCE = 128

SC_WIDTH = D_MODEL // 2
CONV_WIDTH = 3
SWA_HEADS = N_ATTN_HEADS
SWA_KV_HEADS = 2
SWA_HEAD_DIM = (D_MODEL // 2) // SWA_HEADS
SWA_WINDOW = 128
SWA_BLOCK = 128
SWA_Q_WIDTH = SWA_HEADS * SWA_HEAD_DIM
SWA_KV_WIDTH = SWA_KV_HEADS * SWA_HEAD_DIM
D_IN_EVEN = 3 * SC_WIDTH + SWA_Q_WIDTH + 2 * SWA_KV_WIDTH

MOBA_HEADS = N_ATTN_HEADS
MOBA_HEAD_DIM = D_MODEL // MOBA_HEADS
MOBA_BLOCK = 256
MOBA_TOPK = 3
MOBA_Q_CHUNK = 32

D_FF = ((8 * D_MODEL // 3 + 127) // 128) * 128
N_EXPERTS = 8
TOP_K = 2
D_FF_EXPERT = 7 * D_MODEL // 2

N_EVEN = (DEPTH + 1) // 2
N_ODD = DEPTH // 2

kernel_name = "hybrid_conv_swa_moba_moe_trunk"


def rms_norm(x, g):
    xf = x.astype(jnp.float32)
    y = xf * lax.rsqrt(jnp.mean(xf * xf, axis=-1, keepdims=True) + EPS)
    return (y * g.astype(jnp.float32)).astype(x.dtype)


def t5_bucket(dist):
    d = jnp.maximum(dist, 0).astype(jnp.int32)
    max_exact = N_BUCKETS // 2
    scaled = jnp.log(jnp.maximum(d, max_exact).astype(jnp.float32) / max_exact) / math.log(MAX_DISTANCE / max_exact)
    large = jnp.minimum(max_exact + (scaled * (N_BUCKETS - max_exact)).astype(jnp.int32), N_BUCKETS - 1)
    return jnp.where(d < max_exact, d, large)


def short_conv_mixer(b_gate, c_gate, u, conv_w):
    cu = c_gate * u
    y = lax.conv_general_dilated(
        cu, conv_w[:, None, :].astype(cu.dtype), window_strides=(1,),
        padding=[(CONV_WIDTH - 1, 0)], dimension_numbers=("NWC", "WIO", "NWC"),
        feature_group_count=cu.shape[-1])
    return b_gate * y


def sliding_window_attention(q, k, v, sinks, rel_bias):
    bsz, seq, n_h, hd = q.shape
    n_kv = k.shape[2]
    grp = n_h // n_kv
    nb = seq // SWA_BLOCK
    blk = SWA_BLOCK
    qb = q.reshape(bsz, nb, blk, n_kv, grp, hd)

    def band(t):
        tb = t.reshape(bsz, nb, blk, n_kv, hd)
        prev = jnp.concatenate([jnp.zeros_like(tb[:, :1]), tb[:, :-1]], axis=1)
        return jnp.concatenate([prev, tb], axis=2)

    kw, vw = band(k), band(v)
    logits = jnp.einsum("bnqkgd,bnjkd->bnkgqj", qb, kw,
                        preferred_element_type=jnp.float32) * (hd ** -0.5)
    qi = jnp.arange(blk)[:, None]
    kj = jnp.arange(2 * blk)[None, :]
    diff = qi - kj + blk
    kpos = jnp.arange(nb)[:, None, None] * blk - blk + kj[None]
    valid = (diff >= 0)[None] & (diff < SWA_WINDOW)[None] & (kpos >= 0)
    bias = rel_bias[t5_bucket(diff)].astype(jnp.float32)
    bias = bias.transpose(2, 0, 1).reshape(n_kv, grp, blk, 2 * blk)
    logits = jnp.where(valid[None, :, None, None], logits + bias, -jnp.inf)
    sink = jnp.broadcast_to(sinks.astype(jnp.float32).reshape(1, 1, n_kv, grp, 1, 1),
                            logits.shape[:-1] + (1,))
    probs = jax.nn.softmax(jnp.concatenate([logits, sink], axis=-1), axis=-1)[..., :-1]
    out = jnp.einsum("bnkgqj,bnjkd->bnqkgd", probs.astype(v.dtype), vw)
    return out.reshape(bsz, seq, n_h * hd)


def moba_attention(q, k, v, rel_bias):
    bsz, seq, n_h, hd = q.shape
    bs = MOBA_BLOCK
    s_pad = ((seq + bs - 1) // bs) * bs
    pad = [(0, 0), (0, s_pad - seq), (0, 0), (0, 0)]
    q, k, v = jnp.pad(q, pad), jnp.pad(k, pad), jnp.pad(v, pad)
    nblk = s_pad // bs
    topk = min(MOBA_TOPK, nblk)
    scale = hd ** -0.5

    kb = k.reshape(bsz, nblk, bs, n_h, hd)
    kmean = jnp.mean(kb.astype(jnp.float32), axis=2)
    gate = jnp.einsum("bshd,bnhd->bhsn", q.astype(jnp.float32), kmean)
    qblk = jnp.arange(s_pad) // bs
    past = jnp.arange(nblk)[None, :] < qblk[:, None]
    gate = jnp.where(past[None, None], gate, -jnp.inf)
    _, sel = lax.top_k(gate, topk)
    sel_valid = sel < qblk[None, None, :, None]

    kbh = kb.transpose(0, 3, 1, 2, 4)
    vbh = v.reshape(bsz, nblk, bs, n_h, hd).transpose(0, 3, 1, 2, 4)
    bi = jnp.arange(bsz)[:, None, None, None]
    hi = jnp.arange(n_h)[None, :, None, None]
    hi5 = jnp.arange(n_h)[None, :, None, None, None]
    qc_len = MOBA_Q_CHUNK
    n_chunks = s_pad // qc_len

    def chunk(c):
        start = c * qc_len
        qc = lax.dynamic_slice_in_dim(q, start, qc_len, axis=1)
        selc = lax.dynamic_slice_in_dim(sel, start, qc_len, axis=2)
        validc = lax.dynamic_slice_in_dim(sel_valid, start, qc_len, axis=2)
        kg = kbh[bi, hi, selc]
        vg = vbh[bi, hi, selc]
        qpos = start + jnp.arange(qc_len)
        kpos_sel = selc[..., None] * bs + jnp.arange(bs)
        d_sel = qpos[None, None, :, None, None] - kpos_sel
        l_sel = jnp.einsum("bqhd,bhqtjd->bhqtj", qc, kg,
                           preferred_element_type=jnp.float32) * scale
        l_sel = l_sel + rel_bias[t5_bucket(d_sel), hi5].astype(jnp.float32)
        l_sel = jnp.where(validc[..., None], l_sel, -jnp.inf)
        l_sel = l_sel.reshape(bsz, n_h, qc_len, topk * bs)
        own = start // bs
        ko = lax.dynamic_slice_in_dim(k, own * bs, bs, axis=1)
        vo = lax.dynamic_slice_in_dim(v, own * bs, bs, axis=1)
        d_own = qpos[:, None] - (own * bs + jnp.arange(bs))[None, :]
        l_own = jnp.einsum("bqhd,bjhd->bhqj", qc, ko,
                           preferred_element_type=jnp.float32) * scale
        l_own = l_own + rel_bias[t5_bucket(d_own)].astype(jnp.float32).transpose(2, 0, 1)[None]
        l_own = jnp.where((d_own >= 0)[None, None], l_own, -jnp.inf)
        probs = jax.nn.softmax(jnp.concatenate([l_sel, l_own], axis=-1), axis=-1).astype(v.dtype)
        p_sel, p_own = probs[..., : topk * bs], probs[..., topk * bs:]
        out = jnp.einsum("bhqj,bhqjd->bqhd", p_sel, vg.reshape(bsz, n_h, qc_len, topk * bs, hd))
        return out + jnp.einsum("bhqj,bjhd->bqhd", p_own, vo)

    outs = lax.map(chunk, jnp.arange(n_chunks))
    out = outs.transpose(1, 0, 2, 3, 4).reshape(bsz, s_pad, n_h * hd)
    return out[:, :seq]


def swiglu(x, w_gate, w_up, w_down):
    return (jax.nn.silu(x @ w_gate) * (x @ w_up)) @ w_down


def moe_swiglu(x, w_router, w_gate, w_up, w_down):
    logits = (x @ w_router).astype(jnp.float32)
    top_vals, top_idx = lax.top_k(logits, TOP_K)
    top_w = jax.nn.softmax(top_vals, axis=-1)
    gates = jnp.sum(jax.nn.one_hot(top_idx, N_EXPERTS, dtype=jnp.float32) * top_w[..., None], axis=-2)
    out = jnp.zeros_like(x)
    for e in range(N_EXPERTS):
        out = out + gates[..., e:e + 1].astype(x.dtype) * swiglu(x, w_gate[e], w_up[e], w_down[e])
    return out


def per_layer_embedding(h, p_i, g, w_gate, w_proj):
    return h + jax.nn.sigmoid(rms_norm(h, g) @ w_gate) * (p_i @ w_proj)


def setup_inputs(seed: int = 0) -> dict:
    key = jax.random.key(seed)
    ks = iter(jax.random.split(key, 40))
    f32 = jnp.float32

    def dense(shape, fan_in):
        return jax.random.normal(next(ks), shape, f32) * (fan_in ** -0.5)

    def gain(shape):
        return 1.0 + 0.05 * jax.random.normal(next(ks), shape, f32)

    return {
        "x": jax.random.normal(next(ks), (BATCH, SEQ, D_MODEL), f32),
        "p": jax.random.normal(next(ks), (DEPTH, BATCH, SEQ, PLE_DIM), f32),
        "rel_bias": 0.5 * jax.random.normal(next(ks), (N_BUCKETS, N_ATTN_HEADS), f32),
        "final_norm": gain((D_MODEL,)),
        "e_norm_mix": gain((N_EVEN, D_MODEL)),
        "e_w_in": dense((N_EVEN, D_MODEL, D_IN_EVEN), D_MODEL),
        "e_conv_w": dense((N_EVEN, CONV_WIDTH, SC_WIDTH), CONV_WIDTH),
        "e_sinks": 0.5 * jax.random.normal(next(ks), (N_EVEN, SWA_HEADS), f32),
        "e_w_out": dense((N_EVEN, SC_WIDTH + SWA_Q_WIDTH, D_MODEL), SC_WIDTH + SWA_Q_WIDTH),
        "e_norm_ffn": gain((N_EVEN, D_MODEL)),
        "e_ffn_gate": dense((N_EVEN, D_MODEL, D_FF), D_MODEL),
        "e_ffn_up": dense((N_EVEN, D_MODEL, D_FF), D_MODEL),
        "e_ffn_down": dense((N_EVEN, D_FF, D_MODEL), D_FF),
        "e_norm_ple": gain((N_EVEN, D_MODEL)),
        "e_ple_gate": dense((N_EVEN, D_MODEL, D_MODEL), D_MODEL),
        "e_ple_proj": dense((N_EVEN, PLE_DIM, D_MODEL), PLE_DIM),
        "o_norm_mix": gain((N_ODD, D_MODEL)),
        "o_w_qkv": dense((N_ODD, D_MODEL, 3 * D_MODEL), D_MODEL),
        "o_w_o": dense((N_ODD, D_MODEL, D_MODEL), D_MODEL),
        "o_norm_ffn": gain((N_ODD, D_MODEL)),
        "o_router": dense((N_ODD, D_MODEL, N_EXPERTS), D_MODEL),
        "o_exp_gate": dense((N_ODD, N_EXPERTS, D_MODEL, D_FF_EXPERT), D_MODEL),
        "o_exp_up": dense((N_ODD, N_EXPERTS, D_MODEL, D_FF_EXPERT), D_MODEL),
        "o_exp_down": dense((N_ODD, N_EXPERTS, D_FF_EXPERT, D_MODEL), D_FF_EXPERT),
        "o_norm_ple": gain((N_ODD, D_MODEL)),
        "o_ple_gate": dense((N_ODD, D_MODEL, D_MODEL), D_MODEL),
        "o_ple_proj": dense((N_ODD, PLE_DIM, D_MODEL), PLE_DIM),
    }


def reference(x, p, rel_bias, final_norm,
              e_norm_mix, e_w_in, e_conv_w, e_sinks, e_w_out,
              e_norm_ffn, e_ffn_gate, e_ffn_up, e_ffn_down,
              e_norm_ple, e_ple_gate, e_ple_proj,
              o_norm_mix, o_w_qkv, o_w_o, o_norm_ffn, o_router,
              o_exp_gate, o_exp_up, o_exp_down,
              o_norm_ple, o_ple_gate, o_ple_proj):
    bsz, seq, _ = x.shape
    splits_even = [SC_WIDTH, 2 * SC_WIDTH, 3 * SC_WIDTH, 3 * SC_WIDTH + SWA_Q_WIDTH,
                   3 * SC_WIDTH + SWA_Q_WIDTH + SWA_KV_WIDTH]
    h = x
    for i in range(DEPTH):
        j = i // 2
        if i % 2 == 0:
            z = rms_norm(h, e_norm_mix[j]) @ e_w_in[j]
            b_gate, c_gate, u, q, k, v = jnp.split(z, splits_even, axis=-1)
            a_out = short_conv_mixer(b_gate, c_gate, u, e_conv_w[j])
            b_out = sliding_window_attention(
                q.reshape(bsz, seq, SWA_HEADS, SWA_HEAD_DIM),
                k.reshape(bsz, seq, SWA_KV_HEADS, SWA_HEAD_DIM),
                v.reshape(bsz, seq, SWA_KV_HEADS, SWA_HEAD_DIM),
                e_sinks[j], rel_bias)
            h = h + jnp.concatenate([a_out, b_out], axis=-1) @ e_w_out[j]
            h = h + swiglu(rms_norm(h, e_norm_ffn[j]), e_ffn_gate[j], e_ffn_up[j], e_ffn_down[j])
            h = per_layer_embedding(h, p[i], e_norm_ple[j], e_ple_gate[j], e_ple_proj[j])
        else:
            qkv = rms_norm(h, o_norm_mix[j]) @ o_w_qkv[j]
            q, k, v = jnp.split(qkv, 3, axis=-1)
            shp = (bsz, seq, MOBA_HEADS, MOBA_HEAD_DIM)
            c_out = moba_attention(q.reshape(shp), k.reshape(shp), v.reshape(shp), rel_bias)
            h = h + c_out @ o_w_o[j]
            h = h + moe_swiglu(rms_norm(h, o_norm_ffn[j]), o_router[j],
                               o_exp_gate[j], o_exp_up[j], o_exp_down[j])
            h = per_layer_embedding(h, p[i], o_norm_ple[j], o_ple_gate[j], o_ple_proj[j])
    return rms_norm(h, final_norm)
```

```cpp
#include <hip/hip_runtime.h>
#include <cstdio>
#include <cstdint>

#ifndef MK_ONE_LAUNCH
#define MK_ONE_LAUNCH 1
#endif

namespace pg8 {
#define PG8_LAS __attribute__((address_space(3)))
typedef unsigned short bf16_t;
typedef short bf16x8 __attribute__((ext_vector_type(8)));
typedef float f32x4 __attribute__((ext_vector_type(4)));
typedef float f32x2 __attribute__((ext_vector_type(2)));
typedef unsigned u32x4 __attribute__((ext_vector_type(4)));
typedef unsigned u32x2 __attribute__((ext_vector_type(2)));
constexpr int BM = 256, BK = 64, HALF = 128, HTB = HALF * BK * 2, STAGE_BYTES = 8 * HTB, NXCD = 8, WGM = 8;

__host__ __device__ __forceinline__ int lds_byte(int r, int c) { const int st = (r >> 4) * 2 + (c >> 5), rr = r & 15, cc = c & 31, ob = rr * 64 + cc * 2; return st * 1024 + (ob ^ (((ob >> 9) & 1) << 5)); }
__host__ __device__ __forceinline__ void stage_rc(int b, int& R, int& C) { const int st = b / 1024, sb = b % 1024, swz = sb ^ (((sb >> 9) & 1) << 5); R = (st >> 1) * 16 + swz / 64; C = (st & 1) * 32 + (swz % 64) / 2; }
__host__ __device__ __forceinline__ int perm32(int rho) { const int n = rho >> 4, i = rho & 15; return 8 * (i >> 2) + 4 * n + (i & 3); }

struct Unit { int pm, pn, e, mt, nv; };
struct Gemm { const bf16_t* A; const bf16_t* Bt; int K; size_t bslab; };

__device__ __forceinline__ void map_tile(int L, int nwg, int nM, int nN, int& pm, int& pn) {
    int wgid = L; { const int q = nwg / NXCD, r = nwg % NXCD, xcd = wgid % NXCD, off = wgid / NXCD; wgid = (xcd < r ? xcd * (q + 1) : r * (q + 1) + (xcd - r) * q) + off; }
    const int nig = WGM * nN, gid = wgid / nig, fm = gid * WGM, gsz = (nM - fm) < WGM ? (nM - fm) : WGM;
    pm = fm + ((wgid % nig) % gsz); pn = (wgid % nig) / gsz;
}
struct StaticOrder {
    int nM, nN, nwg, G, c;
    __device__ __forceinline__ void init(int M, int N, int G_, int c_) { nM = M / BM; nN = N / BM; nwg = nM * nN; G = G_; c = c_; }
    __device__ __forceinline__ bool next(int i, Unit& u) const {
        const long L = (long)i * G + c; if (L >= nwg) return false;
        map_tile((int)L, nwg, nM, nN, u.pm, u.pn); u.e = 0; u.mt = u.pm; u.nv = 256; return true;
    }
    __device__ __forceinline__ int arow(const Unit& u, int r) const { return u.pm * BM + r; }
};
struct MoeTiles {
    int c0, c1, c2, c3, c4, c5, c6, c7, t1, t2, t3, t4, t5, t6, t7, t8;
    __device__ __forceinline__ static int clampc(int v) { return v < 0 ? 0 : (v > 16384 ? 16384 : v); }
    __device__ __forceinline__ void init(const int* cntp) {
        c0 = clampc(cntp[0]); c1 = clampc(cntp[1]); c2 = clampc(cntp[2]); c3 = clampc(cntp[3]); c4 = clampc(cntp[4]); c5 = clampc(cntp[5]); c6 = clampc(cntp[6]); c7 = clampc(cntp[7]);
        t1 = (c0 + 255) >> 8; t2 = t1 + ((c1 + 255) >> 8); t3 = t2 + ((c2 + 255) >> 8); t4 = t3 + ((c3 + 255) >> 8); t5 = t4 + ((c4 + 255) >> 8); t6 = t5 + ((c5 + 255) >> 8); t7 = t6 + ((c6 + 255) >> 8); t8 = t7 + ((c7 + 255) >> 8);
    }
    __device__ __forceinline__ int base_of(int e) const { return e == 0 ? 0 : e == 1 ? t1 : e == 2 ? t2 : e == 3 ? t3 : e == 4 ? t4 : e == 5 ? t5 : e == 6 ? t6 : t7; }
    __device__ __forceinline__ int cnt_of(int e) const { return e == 0 ? c0 : e == 1 ? c1 : e == 2 ? c2 : e == 3 ? c3 : e == 4 ? c4 : e == 5 ? c5 : e == 6 ? c6 : c7; }
    __device__ __forceinline__ int expert_of(int pm) const { return (pm >= t1) + (pm >= t2) + (pm >= t3) + (pm >= t4) + (pm >= t5) + (pm >= t6) + (pm >= t7); }
};
struct MoeOrder {
    MoeTiles T; int nN, nwg, G, c; const int* tok;
    __device__ __forceinline__ void init(const int* cntp, int nN_, int G_, int c_, const int* tok_) { T.init(cntp); nN = nN_; nwg = T.t8 * nN_; G = G_; c = c_; tok = tok_; }
    __device__ __forceinline__ bool next(int i, Unit& u) const {
        const long L = (long)i * G + c; if (L >= nwg) return false;
        map_tile((int)L, nwg, T.t8, nN, u.pm, u.pn);
        const int e = T.expert_of(u.pm);
        u.e = e; u.mt = u.pm - T.base_of(e); const int rem = T.cnt_of(e) - u.mt * 256; u.nv = rem > 256 ? 256 : rem; return true;
    }
    __device__ __forceinline__ int arow(const Unit& u, int r) const { return r < u.nv ? tok[u.e * 16384 + u.mt * 256 + r] : 0; }
};

__device__ __forceinline__ unsigned cvt_pk_bf16(float lo, float hi) { unsigned r; asm volatile("v_cvt_pk_bf16_f32 %0, %1, %2" : "=v"(r) : "v"(lo), "v"(hi)); return r; }
__device__ __forceinline__ float rstd_of(const float* ssq4, int row) { const f32x4 s = *(const f32x4*)(ssq4 + 4 * (size_t)row); return rsqrtf(((s[0] + s[1]) + (s[2] + s[3])) * (1.0f / 1024.0f) + 1e-6f); }
__device__ __forceinline__ float rstd_from(const f32x4 s) { return rsqrtf(((s[0] + s[1]) + (s[2] + s[3])) * (1.0f / 1024.0f) + 1e-6f); }
__device__ __forceinline__ float silu_f(float x) { return x * __builtin_amdgcn_rcpf(1.0f + __expf(-x)); }
__device__ __forceinline__ float sigmoid_f(float x) { return __builtin_amdgcn_rcpf(1.0f + __expf(-x)); }

struct EpiScaleBf16 {
    static constexpr bool PERM = true, AFTER_DRAIN = false;
    bf16_t* O; int ldc; const float* ssq4; int split_cols; size_t split_stride;
    __device__ __forceinline__ void operator()(const f32x4 (&acc)[2][2][4][2], const Unit& u, int wr, int wc, int fr, int fq) const {
        const int row0 = u.pm * BM + wr * 64 + fr; int colt = u.pn * BM; bf16_t* base = O;
        if (split_cols) { const int t = colt / split_cols; base += (size_t)t * split_stride; colt -= t * split_cols; }
        const int col0 = colt + wc * 32 + 8 * fq;
        f32x4 sq[2][4];
#pragma unroll
        for (int ai = 0; ai < 2; ++ai)
#pragma unroll
            for (int m = 0; m < 4; ++m) sq[ai][m] = *(const f32x4*)(ssq4 + 4 * (size_t)(row0 + ai * HALF + m * 16));
#pragma unroll
        for (int ai = 0; ai < 2; ++ai)
#pragma unroll
            for (int m = 0; m < 4; ++m) { const int row = row0 + ai * HALF + m * 16; const float rs = rstd_from(sq[ai][m]); bf16_t* rowp = base + (size_t)row * ldc + col0;
#pragma unroll
                for (int bj = 0; bj < 2; ++bj) { const f32x4 v0 = acc[ai][bj][m][0] * rs, v1 = acc[ai][bj][m][1] * rs;
                    u32x4 w; w.x = cvt_pk_bf16(v0[0], v0[1]); w.y = cvt_pk_bf16(v0[2], v0[3]); w.z = cvt_pk_bf16(v1[0], v1[1]); w.w = cvt_pk_bf16(v1[2], v1[3]);
                    *(u32x4*)(rowp + bj * HALF) = w; } }
    }
};
template <bool MOE> struct EpiSwiGLU {
    static constexpr bool PERM = true, AFTER_DRAIN = false;
    bf16_t* O; int ldo; const float* rs_src;
    __device__ __forceinline__ void operator()(const f32x4 (&acc)[2][2][4][2], const Unit& u, int wr, int wc, int fr, int fq) const {
        const int col0 = u.pn * HALF + wc * 32 + 8 * fq;
        float rsv[2][4];
#pragma unroll
        for (int ai = 0; ai < 2; ++ai)
#pragma unroll
            for (int m = 0; m < 4; ++m) { const int rl = ai * HALF + wr * 64 + m * 16 + fr;
                if (MOE) rsv[ai][m] = rl < u.nv ? rs_src[u.e * 16384 + u.mt * 256 + rl] : 0.f;
                else { const f32x4 s = *(const f32x4*)(rs_src + 4 * (size_t)(u.pm * BM + rl)); rsv[ai][m] = ((s[0] + s[1]) + (s[2] + s[3])); } }
#pragma unroll
        for (int ai = 0; ai < 2; ++ai)
#pragma unroll
            for (int m = 0; m < 4; ++m) { const int rl = ai * HALF + wr * 64 + m * 16 + fr; const int row = u.pm * BM + rl;
                const float rs = MOE ? rsv[ai][m] : rsqrtf(rsv[ai][m] * (1.0f / 1024.0f) + 1e-6f);
                const f32x4 g0 = acc[ai][0][m][0] * rs, g1 = acc[ai][0][m][1] * rs, u0 = acc[ai][1][m][0] * rs, u1 = acc[ai][1][m][1] * rs;
                u32x4 w;
                w.x = cvt_pk_bf16(silu_f(g0[0]) * u0[0], silu_f(g0[1]) * u0[1]); w.y = cvt_pk_bf16(silu_f(g0[2]) * u0[2], silu_f(g0[3]) * u0[3]);
                w.z = cvt_pk_bf16(silu_f(g1[0]) * u1[0], silu_f(g1[1]) * u1[1]); w.w = cvt_pk_bf16(silu_f(g1[2]) * u1[2], silu_f(g1[3]) * u1[3]);
                *(u32x4*)(O + (size_t)row * ldo + col0) = w; }
    }
};
struct EpiMoeDown {
    static constexpr bool PERM = true, AFTER_DRAIN = false;
    bf16_t* Y; const float* gw;
    __device__ __forceinline__ void operator()(const f32x4 (&acc)[2][2][4][2], const Unit& u, int wr, int wc, int fr, int fq) const {
        const int col0 = u.pn * BM + wc * 32 + 8 * fq;
        float gv[2][4];
#pragma unroll
        for (int ai = 0; ai < 2; ++ai)
#pragma unroll
            for (int m = 0; m < 4; ++m) { const int rl = ai * HALF + wr * 64 + m * 16 + fr; gv[ai][m] = rl < u.nv ? gw[u.e * 16384 + u.mt * 256 + rl] : 0.f; }
#pragma unroll
        for (int ai = 0; ai < 2; ++ai)
#pragma unroll
            for (int m = 0; m < 4; ++m) { const int rl = ai * HALF + wr * 64 + m * 16 + fr; const int row = u.pm * BM + rl;
                const float g = gv[ai][m];
#pragma unroll
                for (int bj = 0; bj < 2; ++bj) { const f32x4 v0 = acc[ai][bj][m][0] * g, v1 = acc[ai][bj][m][1] * g;
                    u32x4 w; w.x = cvt_pk_bf16(v0[0], v0[1]); w.y = cvt_pk_bf16(v0[2], v0[3]); w.z = cvt_pk_bf16(v1[0], v1[1]); w.w = cvt_pk_bf16(v1[2], v1[3]);
                    *(u32x4*)(Y + (size_t)row * 1024 + col0 + bj * HALF) = w; } }
    }
};
struct EpiPP {
    static constexpr bool PERM = false, AFTER_DRAIN = false;
    bf16_t* O;
    __device__ __forceinline__ void operator()(const f32x4 (&acc)[2][2][4][2], const Unit& u, int wr, int wc, int fr, int fq) const {
        const int col0 = u.pn * BM + wc * 32 + 4 * fq;
#pragma unroll
        for (int ai = 0; ai < 2; ++ai)
#pragma unroll
            for (int m = 0; m < 4; ++m) { const size_t off = (size_t)(u.pm * BM + ai * HALF + wr * 64 + m * 16 + fr) * 1024 + col0;
#pragma unroll
                for (int bj = 0; bj < 2; ++bj)
#pragma unroll
                    for (int n = 0; n < 2; ++n) { const f32x4 v = acc[ai][bj][m][n]; u32x2 w; w.x = cvt_pk_bf16(v[0], v[1]); w.y = cvt_pk_bf16(v[2], v[3]); *(u32x2*)(O + off + bj * HALF + n * 16) = w; } }
    }
};
template <bool PLE> struct EpiRes {
    static constexpr bool PERM = false, AFTER_DRAIN = true;
    const float* Hin; float* Hout; bf16_t* XB; float* ssq_out; const float* ssq_in; const bf16_t* PP;
    __device__ __forceinline__ void fused(f32x4 (&acc)[2][2][4][2], const Unit& u, int wr, int wc, int fr, int fq, PG8_LAS unsigned char* lds, int wid, int lane) const {
        PG8_LAS float* P = (PG8_LAS float*)lds;
        const int col0 = u.pn * BM + wc * 32 + 4 * fq;
#pragma unroll
        for (int ai = 0; ai < 2; ++ai)
#pragma unroll
            for (int m = 0; m < 4; ++m) { const int rl = ai * HALF + wr * 64 + m * 16 + fr; const int row = u.pm * BM + rl; const size_t off = (size_t)row * 1024 + col0;
                float rs = 0.f; if (PLE) rs = rstd_of(ssq_in, row);
                float s = 0.f;
#pragma unroll
                for (int bj = 0; bj < 2; ++bj)
#pragma unroll
                    for (int n = 0; n < 2; ++n) { const size_t c = off + bj * HALF + n * 16; const f32x4 hin = *(const f32x4*)(Hin + c); f32x4 v = acc[ai][bj][m][n];
                        if (PLE) { const u32x2 pw = *(const u32x2*)(PP + c);
                            const float p0 = __uint_as_float(pw.x << 16), p1 = __uint_as_float(pw.x & 0xffff0000u), p2 = __uint_as_float(pw.y << 16), p3 = __uint_as_float(pw.y & 0xffff0000u);
                            v[0] = hin[0] + sigmoid_f(v[0] * rs) * p0; v[1] = hin[1] + sigmoid_f(v[1] * rs) * p1; v[2] = hin[2] + sigmoid_f(v[2] * rs) * p2; v[3] = hin[3] + sigmoid_f(v[3] * rs) * p3;
                        } else v = hin + v;
                        *(f32x4*)(Hout + c) = v;
                        if (XB) { u32x2 w; w.x = cvt_pk_bf16(v[0], v[1]); w.y = cvt_pk_bf16(v[2], v[3]); *(u32x2*)(XB + c) = w; }
                        s += (v[0] * v[0] + v[1] * v[1]) + (v[2] * v[2] + v[3] * v[3]); }
                s += __shfl_xor(s, 16); s += __shfl_xor(s, 32);
                if (ssq_out && fq == 0) P[rl * 4 + wc] = s;
                asm volatile("" ::: "memory"); }
        if (ssq_out) {
            asm volatile("s_waitcnt lgkmcnt(0)" ::: "memory"); __builtin_amdgcn_s_barrier(); asm volatile("" ::: "memory");
            const int t = wid * 64 + lane;
            if (t < 256) { const f32x4 q = *(const PG8_LAS f32x4*)(P + t * 4); ssq_out[(size_t)(u.pm * BM + t) * 4 + u.pn] = (q[0] + q[1]) + (q[2] + q[3]); }
            asm volatile("s_waitcnt lgkmcnt(0)" ::: "memory"); __builtin_amdgcn_s_barrier(); asm volatile("" ::: "memory");
        }
    }
};

template <class Epi, class Sched, bool ALIGN_EPI, bool SP2, bool GATHER>
__device__ __forceinline__ void gemm_phase(PG8_LAS unsigned char* lds, const Gemm g, const Sched& S, const Epi& E) {
    int tid_ = threadIdx.x; asm volatile("" : "+v"(tid_));
    const int tid = tid_, wid = __builtin_amdgcn_readfirstlane(tid >> 6), lane = tid & 63, wr = wid >> 2, wc = wid & 3, fr = lane & 15, fq = lane >> 4;
    const int K = g.K, nt = K / BK;
    unsigned voffA[2], voffB[2]; int aR[2], aC[2];
#pragma unroll
    for (int i = 0; i < 2; ++i) { int R, C; stage_rc(tid * 16 + i * 8192, R, C); const int Rb = Epi::PERM ? ((R & ~31) + perm32(R & 31)) : R;
        voffA[i] = (unsigned)(R * K + C) * 2u; voffB[i] = (unsigned)(Rb * K + C) * 2u; aR[i] = R; aC[i] = C; }
    const size_t kstep = (size_t)(BK * 2);
    const size_t hstep = (size_t)HALF * K * 2;
    const size_t tstep = 2 * hstep;
    const unsigned ldsw = (unsigned)wid * 1024u;
    const int aoff = lds_byte(wr * 64 + fr, fq * 8), boff = lds_byte(wc * 32 + fr, fq * 8);
    unsigned gcur[2][2], gnxt[2][2];
#define PG8_SA(b, h) (((b) * 2 + (h)) * HTB)
#define PG8_SB(b, h) ((4 + (b) * 2 + (h)) * HTB)
#define PG8_STAGE(bufoff, gbase, voff) do { _Pragma("unroll") for (int _i = 0; _i < 2; ++_i) \
        __builtin_amdgcn_global_load_lds((const unsigned*)((const char*)(gbase) + (voff)[_i]), (PG8_LAS unsigned*)(lds + (bufoff) + ldsw + _i * 8192), 16, 0, 0); } while (0)
#define PG8_STAGE_A(bufoff, p, h, NX) do { if constexpr (GATHER) { unsigned _vo[2]; _vo[0] = (NX) ? gnxt[h][0] : gcur[h][0]; _vo[1] = (NX) ? gnxt[h][1] : gcur[h][1]; PG8_STAGE(bufoff, p, _vo); } \
        else { PG8_STAGE(bufoff, (p) + (h) * hstep, voffA); } } while (0)
#define PG8_GOFF(dst, uu) do { _Pragma("unroll") for (int _h = 0; _h < 2; ++_h) _Pragma("unroll") for (int _i = 0; _i < 2; ++_i) \
        dst[_h][_i] = ((unsigned)S.arow(uu, _h * HALF + aR[_i]) * (unsigned)K + (unsigned)aC[_i]) * 2u; } while (0)
#define PG8_LDA(dst, b, h) do { _Pragma("unroll") for (int m = 0; m < 4; ++m) _Pragma("unroll") for (int k = 0; k < 2; ++k) dst[m][k] = *(const PG8_LAS bf16x8*)(lds + PG8_SA(b, h) + aoff + m * 2048 + k * 1024); } while (0)
#define PG8_LDB(dst, b, h) do { _Pragma("unroll") for (int n = 0; n < 2; ++n) _Pragma("unroll") for (int k = 0; k < 2; ++k) dst[n][k] = *(const PG8_LAS bf16x8*)(lds + PG8_SB(b, h) + boff + n * 2048 + k * 1024); } while (0)
#define PG8_MMA(ai, bj, At, Bt) do { __builtin_amdgcn_s_setprio(1); _Pragma("unroll") for (int m = 0; m < 4; ++m) _Pragma("unroll") for (int n = 0; n < 2; ++n) _Pragma("unroll") for (int k = 0; k < 2; ++k) \
        acc[ai][bj][m][n] = __builtin_amdgcn_mfma_f32_16x16x32_bf16(Bt[n][k], At[m][k], acc[ai][bj][m][n], 0, 0, 0); __builtin_amdgcn_s_setprio(0); } while (0)
#define PG8_WAIT_V(n) asm volatile("s_waitcnt vmcnt(" #n ")" ::: "memory")
#define PG8_WAIT_L(n) asm volatile("s_waitcnt lgkmcnt(" #n ")" ::: "memory")
#define PG8_BAR __builtin_amdgcn_s_barrier()
#define PG8_SCHED __builtin_amdgcn_sched_barrier(0)
    Unit cur, nxt; int ui = 0;
    if (!S.next(0, cur)) return;
    f32x4 acc[2][2][4][2];
#pragma unroll
    for (int a = 0; a < 2; ++a)
#pragma unroll
        for (int b = 0; b < 2; ++b)
#pragma unroll
            for (int m = 0; m < 4; ++m)
#pragma unroll
                for (int n = 0; n < 2; ++n) acc[a][b][m][n] = (f32x4){0.f, 0.f, 0.f, 0.f};
    bf16x8 At[4][2], B0[2][2], B1[2][2];
    const char* cA = GATHER ? (const char*)g.A : (const char*)g.A + (size_t)cur.pm * tstep;
    const char* cB = (const char*)g.Bt + ((size_t)cur.e * g.bslab) * 2 + (size_t)cur.pn * tstep;
    if constexpr (GATHER) { PG8_GOFF(gcur, cur); PG8_GOFF(gnxt, cur); }
    if constexpr (SP2) {
        PG8_STAGE(PG8_SB(0, 0), cB, voffB); PG8_STAGE(PG8_SB(0, 1), cB + hstep, voffB); PG8_STAGE_A(PG8_SA(0, 0), cA, 0, false); PG8_STAGE_A(PG8_SA(0, 1), cA, 1, false);
        if (wr == 1) PG8_BAR;
        PG8_WAIT_V(2); PG8_BAR;
        PG8_STAGE(PG8_SB(1, 0), cB + kstep, voffB); PG8_STAGE_A(PG8_SA(1, 0), cA + kstep, 0, false); PG8_STAGE(PG8_SB(1, 1), cB + hstep + kstep, voffB);
        PG8_WAIT_V(6); PG8_BAR;
    } else {
        PG8_STAGE(PG8_SB(0, 0), cB, voffB); PG8_STAGE_A(PG8_SA(0, 0), cA, 0, false); PG8_STAGE(PG8_SB(0, 1), cB + hstep, voffB); PG8_STAGE_A(PG8_SA(0, 1), cA, 1, false);
        if (wr == 1) PG8_BAR;
        PG8_WAIT_V(4); PG8_BAR;
        PG8_STAGE(PG8_SB(1, 0), cB + kstep, voffB); PG8_STAGE_A(PG8_SA(1, 0), cA + kstep, 0, false); PG8_STAGE(PG8_SB(1, 1), cB + hstep + kstep, voffB);
        PG8_WAIT_V(6); PG8_BAR;
    }
    for (;;) {
        const bool has_next = S.next(ui + 1, nxt);
        const char* nA = GATHER ? (const char*)g.A : (has_next ? (const char*)g.A + (size_t)nxt.pm * tstep : cA);
        const char* nB = has_next ? (const char*)g.Bt + ((size_t)nxt.e * g.bslab) * 2 + (size_t)nxt.pn * tstep : cB;
        if constexpr (GATHER) { if (has_next) { PG8_GOFF(gnxt, nxt); } else {
#pragma unroll
            for (int _h = 0; _h < 2; ++_h)
#pragma unroll
                for (int _i = 0; _i < 2; ++_i) gnxt[_h][_i] = gcur[_h][_i]; } }
        for (int t = 0; t < nt; t += 2) {
            const bool last = (t == nt - 2);
            const char* a1 = cA + (size_t)(t + 1) * kstep;
            const char* a2 = last ? nA : cA + (size_t)(t + 2) * kstep; const char* b2 = last ? nB : cB + (size_t)(t + 2) * kstep;
            const char* a3 = a2 + kstep; const char* b3 = b2 + kstep;
            if constexpr (SP2) {
            PG8_LDB(B0, 0, 0); PG8_LDB(B1, 0, 1); PG8_SCHED; PG8_LDA(At, 0, 0); PG8_STAGE_A(PG8_SA(1, 1), a1, 1, false);
            PG8_WAIT_V(8); PG8_WAIT_L(0); PG8_BAR; PG8_MMA(0, 0, At, B0); PG8_MMA(0, 1, At, B1); PG8_BAR; PG8_SCHED;
            PG8_LDA(At, 0, 1); PG8_STAGE(PG8_SB(0, 0), b2, voffB); PG8_STAGE(PG8_SB(0, 1), b2 + hstep, voffB); PG8_STAGE_A(PG8_SA(0, 0), a2, 0, last);
            PG8_WAIT_V(8); PG8_WAIT_L(0); PG8_BAR; PG8_MMA(1, 0, At, B0); PG8_MMA(1, 1, At, B1); PG8_BAR; PG8_SCHED;
            PG8_LDB(B0, 1, 0); PG8_LDB(B1, 1, 1); PG8_SCHED; PG8_LDA(At, 1, 0); PG8_STAGE_A(PG8_SA(0, 1), a2, 1, last);
            PG8_WAIT_V(8); PG8_WAIT_L(0); PG8_BAR; PG8_MMA(0, 0, At, B0); PG8_MMA(0, 1, At, B1); PG8_BAR; PG8_SCHED;
            PG8_LDA(At, 1, 1); PG8_STAGE(PG8_SB(1, 0), b3, voffB); PG8_STAGE(PG8_SB(1, 1), b3 + hstep, voffB); PG8_STAGE_A(PG8_SA(1, 0), a3, 0, last);
            PG8_WAIT_V(8); PG8_WAIT_L(0); PG8_BAR; PG8_MMA(1, 0, At, B0); PG8_MMA(1, 1, At, B1); PG8_BAR; PG8_SCHED;
            } else {
            PG8_LDB(B0, 0, 0); PG8_SCHED; PG8_LDA(At, 0, 0); PG8_STAGE_A(PG8_SA(1, 1), a1, 1, false);
            PG8_WAIT_L(8); PG8_BAR; PG8_WAIT_L(0); PG8_MMA(0, 0, At, B0); PG8_BAR; PG8_SCHED;
            PG8_LDB(B1, 0, 1); PG8_STAGE(PG8_SB(0, 0), b2, voffB);
            PG8_BAR; PG8_WAIT_L(0); PG8_MMA(0, 1, At, B1); PG8_BAR;
            PG8_LDA(At, 0, 1); PG8_STAGE_A(PG8_SA(0, 0), a2, 0, last);
            PG8_BAR; PG8_WAIT_L(0); PG8_MMA(1, 0, At, B0); PG8_BAR; PG8_SCHED;
            PG8_STAGE(PG8_SB(0, 1), b2 + hstep, voffB);
            PG8_WAIT_V(6); PG8_BAR; PG8_MMA(1, 1, At, B1); PG8_BAR;
            PG8_LDB(B0, 1, 0); PG8_SCHED; PG8_LDA(At, 1, 0); PG8_STAGE_A(PG8_SA(0, 1), a2, 1, last);
            PG8_WAIT_L(8); PG8_BAR; PG8_WAIT_L(0); PG8_MMA(0, 0, At, B0); PG8_BAR; PG8_SCHED;
            PG8_LDB(B1, 1, 1); PG8_STAGE(PG8_SB(1, 0), b3, voffB);
            PG8_BAR; PG8_WAIT_L(0); PG8_MMA(0, 1, At, B1); PG8_BAR;
            PG8_LDA(At, 1, 1); PG8_STAGE_A(PG8_SA(1, 0), a3, 0, last);
            PG8_BAR; PG8_WAIT_L(0); PG8_MMA(1, 0, At, B0); PG8_BAR; PG8_SCHED;
            PG8_STAGE(PG8_SB(1, 1), b3 + hstep, voffB);
            PG8_WAIT_V(6); PG8_BAR; PG8_MMA(1, 1, At, B1); PG8_BAR;
            }
        }
        if constexpr (ALIGN_EPI) { if (wr == 0) PG8_BAR; }
        if constexpr (!Epi::AFTER_DRAIN) { E(acc, cur, wr, wc, fr, fq); }
        if (!has_next) break;
#pragma unroll
        for (int a = 0; a < 2; ++a)
#pragma unroll
            for (int b = 0; b < 2; ++b)
#pragma unroll
                for (int m = 0; m < 4; ++m)
#pragma unroll
                    for (int n = 0; n < 2; ++n) acc[a][b][m][n] = (f32x4){0.f, 0.f, 0.f, 0.f};
        cur = nxt; cA = nA; cB = nB; ++ui;
        if constexpr (GATHER) {
#pragma unroll
            for (int _h = 0; _h < 2; ++_h)
#pragma unroll
                for (int _i = 0; _i < 2; ++_i) gcur[_h][_i] = gnxt[_h][_i]; }
        if constexpr (ALIGN_EPI) { if (wr == 1) PG8_BAR; }
    }
    PG8_WAIT_V(0);
    if constexpr (!ALIGN_EPI) { if (wr == 0) PG8_BAR; }
    PG8_BAR;
    if constexpr (Epi::AFTER_DRAIN) { E.fused(acc, cur, wr, wc, fr, fq, lds, wid, lane); }
#undef PG8_SA
#undef PG8_SB
#undef PG8_STAGE
#undef PG8_STAGE_A
#undef PG8_GOFF
#undef PG8_LDA
#undef PG8_LDB
#undef PG8_MMA
#undef PG8_WAIT_V
#undef PG8_WAIT_L
#undef PG8_BAR
#undef PG8_SCHED
}
}

constexpr int NWAVES = 8;
constexpr int BATCH = 2, SEQ = 8192, M = BATCH * SEQ, D = 1024;
constexpr int DIN0 = 2304, DFF0 = 2816, DFE = 3584, NEXP = 8, PLE = 256;
constexpr int ZC_B = 0, ZC_C = 512, ZC_U = 1024, ZC_Q = 1536, ZC_K = 2048, ZC_V = 2176;
constexpr int HMG_ROWS = 34816;
constexpr float EPS = 1e-6f;

constexpr size_t MiB = 1u << 20;
constexpr size_t WS_CTL = 0, CTL_ZERO_BYTES = 1 * MiB;
constexpr size_t WS_SSQA = 1 * MiB, WS_SSQB = WS_SSQA + 256 * 1024;
constexpr size_t WS_TOKE = 2 * MiB, WS_GWE = WS_TOKE + 512 * 1024, WS_RSE = WS_GWE + 512 * 1024, WS_POS = WS_RSE + 512 * 1024;
constexpr size_t WS_KM = 4 * MiB;
constexpr size_t WS_W = 16 * MiB;
constexpr size_t W_IN = WS_W, W_OUT = W_IN + (size_t)DIN0 * D * 2, W_GU0 = W_OUT + (size_t)D * D * 2, W_D0 = W_GU0 + (size_t)2 * DFF0 * D * 2,
                 W_PG0 = W_D0 + (size_t)D * DFF0 * 2, W_PP0 = W_PG0 + (size_t)D * D * 2, W_QKV = W_PP0 + (size_t)D * PLE * 2, W_O = W_QKV + (size_t)3 * D * D * 2,
                 W_PG1 = W_O + (size_t)D * D * 2, W_PP1 = W_PG1 + (size_t)D * D * 2, W_EGU = W_PP1 + (size_t)D * PLE * 2, W_ED = W_EGU + (size_t)NEXP * 2 * DFE * D * 2,
                 W_END = W_ED + (size_t)NEXP * D * DFE * 2;
constexpr size_t WS_XBA = 220 * MiB;
constexpr size_t WS_R = 252 * MiB;
static_assert(W_END <= WS_XBA, "weights overflow");
constexpr size_t R_Z = WS_R, R_MIX = WS_R + 72 * MiB, R_HM0 = WS_R, R_XBB = WS_R + 104 * MiB, R_PP = WS_R + 136 * MiB, R_PB0 = WS_R + 168 * MiB;
constexpr size_t R_Q = WS_R, R_K = WS_R + 32 * MiB, R_V = WS_R + 64 * MiB, R_ATT = WS_R + 136 * MiB;
constexpr size_t R_HMG = WS_R;
constexpr size_t R_Y = W_EGU;
constexpr size_t R_PB1 = WS_R, R_PP1 = WS_R + 8 * MiB;
constexpr size_t WS_END = WS_R + 238 * MiB;
static_assert((size_t)HMG_ROWS * DFE * 2 <= 238 * MiB, "HMg");
static_assert((size_t)HMG_ROWS * D * 2 <= (size_t)NEXP * 2 * DFE * D * 2, "Y overlay");
constexpr int CW_BAR = 4096;
constexpr int CW_ECNT = 16384;

constexpr int RING_BYTES = 131072;
constexpr int LDSCTL_OFF = RING_BYTES, MISC_OFF = LDSCTL_OFF + 320;
constexpr int LDS_BYTES = 147456;

#define GAS __attribute__((address_space(1)))
#define LAS __attribute__((address_space(3)))
typedef unsigned short bf16;
typedef unsigned v4u __attribute__((ext_vector_type(4)));
typedef unsigned v2u __attribute__((ext_vector_type(2)));
typedef float f32x4 __attribute__((ext_vector_type(4)));
typedef GAS unsigned gu32;
#define RLX_AGENT __ATOMIC_RELAXED, __HIP_MEMORY_SCOPE_AGENT
#define LDS_WAIT() asm volatile("s_waitcnt lgkmcnt(0)" ::: "memory")
#define VM_WAIT() asm volatile("s_waitcnt vmcnt(0)" ::: "memory")
__device__ __forceinline__ unsigned pk2(float lo, float hi) { return pg8::cvt_pk_bf16(lo, hi); }
__device__ __forceinline__ float bflo(unsigned w) { return __uint_as_float(w << 16); }
__device__ __forceinline__ float bfhi(unsigned w) { return __uint_as_float(w & 0xffff0000u); }

#define XB_TMO      128
#define XB_XCNT(j)  (256  + 64 * (j))
#define XB_XSUB(j)  (1280 + 64 * (j))
#define XB_XGEN(j)  (2304 + 64 * (j))
#define XB_TOP      3328
#define XB_TOPGEN   3392
#define XCD_BAR_WORDS 3456
#define XB_SPIN_CAP (1u << 18)
__device__ __forceinline__ unsigned xb_ld(unsigned* p)              { return __hip_atomic_load(p, __ATOMIC_RELAXED, __HIP_MEMORY_SCOPE_AGENT); }
__device__ __forceinline__ unsigned xb_add(unsigned* p, unsigned v) { return __hip_atomic_fetch_add(p, v, __ATOMIC_RELAXED, __HIP_MEMORY_SCOPE_AGENT); }
__device__ __forceinline__ unsigned xb_xcc_id() { return (unsigned)__builtin_amdgcn_s_getreg((3 << 11) | 20) & 0xFu; }
#define XB_SPIN(cond, bar) do { unsigned _sp = 0; while (cond) { __builtin_amdgcn_s_sleep(1); \
    if ((++_sp & 255u) == 0u) { if (xb_ld(&(bar)[XB_TMO])) break; if (_sp > XB_SPIN_CAP) { atomicAdd(&(bar)[XB_TMO], 1u); break; } } } } while (0)
struct XcdBarrier { unsigned* bar; unsigned x; volatile LAS unsigned* st; };
__device__ __forceinline__ XcdBarrier xcd_barrier_post(unsigned* bar, volatile LAS unsigned* st) {
    XcdBarrier b; b.bar = bar; b.x = xb_xcc_id(); b.st = st;
    if (threadIdx.x == 0) (void)xb_add(&bar[XB_XCNT(b.x)], 1u);
    return b;
}
__device__ __forceinline__ void xcd_barrier_complete(unsigned* bar, unsigned x, unsigned& nloc, unsigned& nx) {
    const unsigned G = gridDim.x * gridDim.y * gridDim.z;
    unsigned sum, cnt, mine, sp = 0u;
    for (;;) {
        sum = 0u; cnt = 0u; mine = 0u;
#pragma unroll
        for (unsigned j = 0; j < 16; ++j) { const unsigned c = xb_ld(&bar[XB_XCNT(j)]); sum += c; cnt += (c > 0u) ? 1u : 0u; mine = (j == x) ? c : mine; }
        if (sum == G) break;
        __builtin_amdgcn_s_sleep(1);
        if ((++sp & 255u) == 0u) { if (xb_ld(&bar[XB_TMO])) break; if (sp > XB_SPIN_CAP) { atomicAdd(&bar[XB_TMO], 1u); break; } }
    }
    nloc = mine > 0u ? mine : 1u; nx = cnt > 0u ? cnt : 1u;
}
__device__ __forceinline__ void xcd_barrier(const XcdBarrier& b) {
    asm volatile("s_waitcnt vmcnt(0)" ::: "memory");
    __syncthreads();
    if (threadIdx.x == 0) {
        unsigned* bar = b.bar;
        __builtin_amdgcn_s_waitcnt(0);
        unsigned nloc = b.st[0], nx = b.st[1];
        if (nloc == 0u) { xcd_barrier_complete(bar, b.x, nloc, nx); b.st[0] = nloc; b.st[1] = nx; }
        const unsigned old = xb_add(&bar[XB_XSUB(b.x)], 1u);
        const unsigned gen = old / nloc;
        if (old + 1u == (gen + 1u) * nloc) {
            __builtin_amdgcn_fence(__ATOMIC_RELEASE, "agent");
            asm volatile("s_waitcnt vmcnt(0)" ::: "memory");
            const unsigned og = xb_add(&bar[XB_TOP], 1u);
            const unsigned tg = og / nx;
            if (og + 1u == (tg + 1u) * nx) xb_add(&bar[XB_TOPGEN], 1u);
            else XB_SPIN(xb_ld(&bar[XB_TOPGEN]) == tg, bar);
            __builtin_amdgcn_fence(__ATOMIC_ACQUIRE, "agent");
            xb_add(&bar[XB_XGEN(b.x)], 1u);
            asm volatile("s_waitcnt vmcnt(0)" ::: "memory");
        } else {
            XB_SPIN(xb_ld(&bar[XB_XGEN(b.x)]) == gen, bar);
            __builtin_amdgcn_fence(__ATOMIC_ACQUIRE, "agent");
            asm volatile("s_waitcnt vmcnt(0)" ::: "memory");
        }
    }
    __syncthreads();
}

struct Args { const float* in[27]; float* out; unsigned char* ws; int ph_lo, ph_hi; };
struct Frame {
    LAS unsigned char* lds;
    volatile LAS unsigned* MISC;
    gu32* ctl;
    int tid, lane, wave, G;
    unsigned char* ws;
    float* H;
};
__device__ __forceinline__ float wave_sum(float v) {
#pragma unroll
    for (int o = 1; o < 64; o <<= 1) v += __shfl_xor(v, o);
    return v;
}
__device__ __forceinline__ float wave_max(float v) {
#pragma unroll
    for (int o = 1; o < 64; o <<= 1) v = fmaxf(v, __shfl_xor(v, o));
    return v;
}
__device__ __forceinline__ int t5_bucket(int d) {
    if (d < 16) return d;
    int b = 16;
    b += d >= 19; b += d >= 21; b += d >= 24; b += d >= 27; b += d >= 31; b += d >= 35; b += d >= 40; b += d >= 46;
    b += d >= 52; b += d >= 59; b += d >= 67; b += d >= 77; b += d >= 87; b += d >= 99; b += d >= 113;
    return b;
}
__device__ __forceinline__ void fill_blut(LAS float* blut, const float* rel_bias, int tid) {
    for (int i = tid; i < 1024; i += NWAVES * 64) { const int h = i >> 7, d = i & 127; blut[i] = rel_bias[t5_bucket(d) * 8 + h]; }
}

__device__ __forceinline__ void p0_transpose_item(const float* W, int K, int N, const float* gain, bf16* WT, int mode, LAS float* scr, int item, int lane) {
    const int nblk = N / 32, kb = item / nblk, nb = item % nblk, k0 = 64 * kb, n0 = 32 * nb;
#pragma unroll 8
    for (int i = 0; i < 32; ++i) { const int kk = 2 * i + (lane >> 5); float w = W[(size_t)(k0 + kk) * N + n0 + (lane & 31)]; if (gain) w *= gain[k0 + kk]; scr[kk * 33 + (lane & 31)] = w; }
    LDS_WAIT(); asm volatile("" ::: "memory");
    const int c = lane & 7;
#pragma unroll
    for (int j = 0; j < 4; ++j) { const int n = (lane >> 3) + 8 * j; const LAS float* s = scr + (8 * c) * 33 + n;
        v4u o; o.x = pk2(s[0 * 33], s[1 * 33]); o.y = pk2(s[2 * 33], s[3 * 33]); o.z = pk2(s[4 * 33], s[5 * 33]); o.w = pk2(s[6 * 33], s[7 * 33]);
        const int nn = n0 + n; const int drow = mode == 0 ? nn : (256 * (nn >> 7) + (nn & 127) + (mode == 2 ? 128 : 0));
        *(GAS v4u*)(WT + (size_t)drow * K + k0 + 8 * c) = o; }
    LDS_WAIT(); asm volatile("" ::: "memory");
}
__device__ __forceinline__ float row_to_bf16_ssq(const float* xrow, bf16* orow, int lane) {
    const GAS f32x4* xr = (const GAS f32x4*)xrow + lane;
    f32x4 v[4]; float s = 0.f;
#pragma unroll
    for (int j = 0; j < 4; ++j) { v[j] = xr[64 * j]; s += (v[j].x * v[j].x + v[j].y * v[j].y) + (v[j].z * v[j].z + v[j].w * v[j].w); }
    GAS v2u* o8 = (GAS v2u*)orow + lane;
#pragma unroll
    for (int j = 0; j < 4; ++j) { v2u w; w.x = pk2(v[j].x, v[j].y); w.y = pk2(v[j].z, v[j].w); o8[64 * j] = w; }
    return wave_sum(s);
}
__device__ __forceinline__ void cvt_f32_bf16_flat(const float* src, bf16* dst, size_t n8, int gt, int ngt) {
    for (size_t i = gt; i < n8; i += ngt) { const f32x4 a = ((const GAS f32x4*)src)[2 * i], b = ((const GAS f32x4*)src)[2 * i + 1];
        v4u o; o.x = pk2(a.x, a.y); o.y = pk2(a.z, a.w); o.z = pk2(b.x, b.y); o.w = pk2(b.z, b.w); ((GAS v4u*)dst)[i] = o; }
}
__device__ __forceinline__ void p0_prologue(Frame& F, const Args& a) {
    LAS float* scr = (LAS float*)(F.lds + F.wave * 16384);
    const int gw = blockIdx.x * NWAVES + F.wave, NGW = F.G * NWAVES;
    unsigned char* ws = F.ws;
    constexpr int I_WIN = 16 * 72, I_SQ = 16 * 32, I_F0 = 16 * 88, I_D0 = 44 * 32, I_PP = 4 * 32, I_QKV = 16 * 96, I_EG = 16 * 112, I_ED = 56 * 32;
    constexpr int NITEMS = I_WIN + I_SQ + 2 * I_F0 + I_D0 + I_SQ + I_PP + I_QKV + I_SQ + I_SQ + I_PP + 8 * (2 * I_EG + I_ED);
    for (int it = gw; it < NITEMS; it += NGW) {
        int r = it;
        if (r < I_WIN) { p0_transpose_item(a.in[5], D, DIN0, a.in[4], (bf16*)(ws + W_IN), 0, scr, r, F.lane); continue; } r -= I_WIN;
        if (r < I_SQ) { p0_transpose_item(a.in[8], D, D, nullptr, (bf16*)(ws + W_OUT), 0, scr, r, F.lane); continue; } r -= I_SQ;
        if (r < I_F0) { p0_transpose_item(a.in[10], D, DFF0, a.in[9], (bf16*)(ws + W_GU0), 1, scr, r, F.lane); continue; } r -= I_F0;
        if (r < I_F0) { p0_transpose_item(a.in[11], D, DFF0, a.in[9], (bf16*)(ws + W_GU0), 2, scr, r, F.lane); continue; } r -= I_F0;
        if (r < I_D0) { p0_transpose_item(a.in[12], DFF0, D, nullptr, (bf16*)(ws + W_D0), 0, scr, r, F.lane); continue; } r -= I_D0;
        if (r < I_SQ) { p0_transpose_item(a.in[14], D, D, a.in[13], (bf16*)(ws + W_PG0), 0, scr, r, F.lane); continue; } r -= I_SQ;
        if (r < I_PP) { p0_transpose_item(a.in[15], PLE, D, nullptr, (bf16*)(ws + W_PP0), 0, scr, r, F.lane); continue; } r -= I_PP;
        if (r < I_QKV) { p0_transpose_item(a.in[17], D, 3 * D, a.in[16], (bf16*)(ws + W_QKV), 0, scr, r, F.lane); continue; } r -= I_QKV;
        if (r < I_SQ) { p0_transpose_item(a.in[18], D, D, nullptr, (bf16*)(ws + W_O), 0, scr, r, F.lane); continue; } r -= I_SQ;
        if (r < I_SQ) { p0_transpose_item(a.in[25], D, D, a.in[24], (bf16*)(ws + W_PG1), 0, scr, r, F.lane); continue; } r -= I_SQ;
        if (r < I_PP) { p0_transpose_item(a.in[26], PLE, D, nullptr, (bf16*)(ws + W_PP1), 0, scr, r, F.lane); continue; } r -= I_PP;
        const int e = r / (2 * I_EG + I_ED); r -= e * (2 * I_EG + I_ED);
        if (r < I_EG) { p0_transpose_item(a.in[21] + (size_t)e * D * DFE, D, DFE, a.in[19], (bf16*)(ws + W_EGU) + (size_t)e * 2 * DFE * D, 1, scr, r, F.lane); continue; } r -= I_EG;
        if (r < I_EG) { p0_transpose_item(a.in[22] + (size_t)e * D * DFE, D, DFE, a.in[19], (bf16*)(ws + W_EGU) + (size_t)e * 2 * DFE * D, 2, scr, r, F.lane); continue; } r -= I_EG;
        p0_transpose_item(a.in[23] + (size_t)e * DFE * D, DFE, D, nullptr, (bf16*)(ws + W_ED) + (size_t)e * D * DFE, 0, scr, r, F.lane);
    }
    for (int m = gw; m < M; m += NGW) { const float s = row_to_bf16_ssq(a.in[0] + (size_t)m * D, (bf16*)(ws + WS_XBA) + (size_t)m * D, F.lane);
        if (F.lane == 0) *(GAS f32x4*)((float*)(ws + WS_SSQA) + 4 * (size_t)m) = (f32x4){s, 0.f, 0.f, 0.f}; }
    cvt_f32_bf16_flat(a.in[1], (bf16*)(ws + R_PB0), (size_t)M * PLE / 8, blockIdx.x * (NWAVES * 64) + F.tid, F.G * NWAVES * 64);
}

__device__ __forceinline__ void l0_mixer_naive(Frame& F, const Args& a) {
    const bf16* Z = (const bf16*)(F.ws + R_Z); bf16* MIX = (bf16*)(F.ws + R_MIX);
    const int gw = blockIdx.x * NWAVES + F.wave, NGW = F.G * NWAVES, lane = F.lane;
    {
        const float* cw = a.in[6];
        const int c0 = lane * 8;
        float w0[8], w1[8], w2[8];
#pragma unroll
        for (int j = 0; j < 8; ++j) { w0[j] = cw[c0 + j]; w1[j] = cw[512 + c0 + j]; w2[j] = cw[1024 + c0 + j]; }
        for (int tok = gw; tok < M; tok += NGW) {
            const int t = tok & (SEQ - 1);
            float acc[8];
#pragma unroll
            for (int j = 0; j < 8; ++j) acc[j] = 0.f;
#pragma unroll
            for (int dt = 0; dt < 3; ++dt) {
                if (t - dt >= 0) {
                    const bf16* zr = Z + (size_t)(tok - dt) * DIN0;
                    const v4u cc = *(const GAS v4u*)(zr + ZC_C + c0), uu = *(const GAS v4u*)(zr + ZC_U + c0);
                    const unsigned cw4[4] = {cc.x, cc.y, cc.z, cc.w}, uw4[4] = {uu.x, uu.y, uu.z, uu.w};
#pragma unroll
                    for (int q = 0; q < 4; ++q) { const float p0 = bflo(cw4[q]) * bflo(uw4[q]), p1 = bfhi(cw4[q]) * bfhi(uw4[q]);
                        const float wa = dt == 0 ? w2[2 * q] : (dt == 1 ? w1[2 * q] : w0[2 * q]), wb = dt == 0 ? w2[2 * q + 1] : (dt == 1 ? w1[2 * q + 1] : w0[2 * q + 1]);
                        acc[2 * q] += wa * p0; acc[2 * q + 1] += wb * p1; }
                }
            }
            const v4u bb = *(const GAS v4u*)(Z + (size_t)tok * DIN0 + ZC_B + c0);
            v4u o; o.x = pk2(bflo(bb.x) * acc[0], bfhi(bb.x) * acc[1]); o.y = pk2(bflo(bb.y) * acc[2], bfhi(bb.y) * acc[3]);
            o.z = pk2(bflo(bb.z) * acc[4], bfhi(bb.z) * acc[5]); o.w = pk2(bflo(bb.w) * acc[6], bfhi(bb.w) * acc[7]);
            *(GAS v4u*)(MIX + (size_t)tok * D + c0) = o;
        }
    }
    LAS float* blut = (LAS float*)F.lds;
    fill_blut(blut, a.in[2], F.tid);
    __syncthreads();
    LAS float* qs = (LAS float*)(F.lds + 4096 + F.wave * 3072); LAS float* Ps = qs + 256;
    const float* sinks = a.in[7];
    for (int task = gw; task < 2 * M; task += NGW) {
        const int tok = task >> 1, kvh = task & 1, b = tok >> 13, t = tok & (SEQ - 1);
        const bf16* zrow = Z + (size_t)tok * DIN0;
        { const v2u w = *(const GAS v2u*)(zrow + ZC_Q + kvh * 256 + lane * 4);
          qs[lane * 4 + 0] = bflo(w.x); qs[lane * 4 + 1] = bfhi(w.x); qs[lane * 4 + 2] = bflo(w.y); qs[lane * 4 + 3] = bfhi(w.y); }
        LDS_WAIT();
        float sc[4][2];
#pragma unroll 1
        for (int jj = 0; jj < 2; ++jj) { const int kp = t - 127 + lane + 64 * jj; const int kpc = kp < 0 ? 0 : kp;
            const GAS v4u* kr = (const GAS v4u*)(Z + (size_t)(b * SEQ + kpc) * DIN0 + ZC_K + kvh * 64);
            float a0 = 0.f, a1 = 0.f, a2 = 0.f, a3 = 0.f;
#pragma unroll 2
            for (int c = 0; c < 8; ++c) { const v4u kw = kr[c];
                const float k0 = bflo(kw.x), k1 = bfhi(kw.x), k2 = bflo(kw.y), k3 = bfhi(kw.y), k4 = bflo(kw.z), k5 = bfhi(kw.z), k6 = bflo(kw.w), k7 = bfhi(kw.w);
                { const f32x4 qa = *(const LAS f32x4*)(qs + 0 * 64 + c * 8), qb = *(const LAS f32x4*)(qs + 0 * 64 + c * 8 + 4); a0 += (qa.x * k0 + qa.y * k1) + (qa.z * k2 + qa.w * k3) + (qb.x * k4 + qb.y * k5) + (qb.z * k6 + qb.w * k7); }
                { const f32x4 qa = *(const LAS f32x4*)(qs + 1 * 64 + c * 8), qb = *(const LAS f32x4*)(qs + 1 * 64 + c * 8 + 4); a1 += (qa.x * k0 + qa.y * k1) + (qa.z * k2 + qa.w * k3) + (qb.x * k4 + qb.y * k5) + (qb.z * k6 + qb.w * k7); }
                { const f32x4 qa = *(const LAS f32x4*)(qs + 2 * 64 + c * 8), qb = *(const LAS f32x4*)(qs + 2 * 64 + c * 8 + 4); a2 += (qa.x * k0 + qa.y * k1) + (qa.z * k2 + qa.w * k3) + (qb.x * k4 + qb.y * k5) + (qb.z * k6 + qb.w * k7); }
                { const f32x4 qa = *(const LAS f32x4*)(qs + 3 * 64 + c * 8), qb = *(const LAS f32x4*)(qs + 3 * 64 + c * 8 + 4); a3 += (qa.x * k0 + qa.y * k1) + (qa.z * k2 + qa.w * k3) + (qb.x * k4 + qb.y * k5) + (qb.z * k6 + qb.w * k7); }
            }
            if (jj == 0) { sc[0][0] = a0; sc[1][0] = a1; sc[2][0] = a2; sc[3][0] = a3; } else { sc[0][1] = a0; sc[1][1] = a1; sc[2][1] = a2; sc[3][1] = a3; }
        }
#pragma unroll
        for (int g = 0; g < 4; ++g) {
            const int h = kvh * 4 + g;
            float s0, s1;
            { const int j = lane; s0 = (t - 127 + j >= 0) ? sc[g][0] * 0.125f + blut[h * 128 + 127 - j] : -INFINITY; }
            { const int j = lane + 64; s1 = (t - 127 + j >= 0) ? sc[g][1] * 0.125f + blut[h * 128 + 127 - j] : -INFINITY; }
            const float sink = sinks[h];
            const float mx = fmaxf(wave_max(fmaxf(s0, s1)), sink);
            const float p0 = __expf(s0 - mx), p1 = __expf(s1 - mx);
            const float den = wave_sum(p0 + p1) + __expf(sink - mx);
            const float inv = 1.0f / den;
            Ps[lane * 4 + g] = p0 * inv; Ps[(lane + 64) * 4 + g] = p1 * inv;
        }
        LDS_WAIT();
        float o[4] = {0.f, 0.f, 0.f, 0.f};
        const bf16* vbase = Z + (size_t)(b * SEQ) * DIN0 + ZC_V + kvh * 64 + lane;
        for (int j = 0; j < 128; ++j) { const int kp = t - 127 + j; const int kpc = kp < 0 ? 0 : kp;
            const float v = __uint_as_float((unsigned)vbase[(size_t)kpc * DIN0] << 16); const f32x4 p = *(const LAS f32x4*)(Ps + j * 4);
            o[0] += p.x * v; o[1] += p.y * v; o[2] += p.z * v; o[3] += p.w * v; }
#pragma unroll
        for (int g = 0; g < 4; ++g) MIX[(size_t)tok * D + 512 + (kvh * 4 + g) * 64 + lane] = (bf16)(pk2(o[g], 0.f) & 0xffffu);
        LDS_WAIT();
    }
}

__device__ __forceinline__ void l1_kmean(Frame& F) {
    const bf16* Kb = (const bf16*)(F.ws + R_K); float* KM = (float*)(F.ws + WS_KM);
    LAS float* red = (LAS float*)F.lds;
    for (int task = blockIdx.x; task < 2 * 32 * 8; task += F.G) {
        const int h = task & 7, bn = task >> 3;
        const bf16* base = Kb + (size_t)(bn * 256 + F.wave * 32) * D + h * 128 + 2 * F.lane;
        float s0 = 0.f, s1 = 0.f;
        for (int r = 0; r < 32; ++r) { const unsigned w = *(const GAS unsigned*)(base + (size_t)r * D); s0 += bflo(w); s1 += bfhi(w); }
        red[F.wave * 128 + 2 * F.lane] = s0; red[F.wave * 128 + 2 * F.lane + 1] = s1;
        __syncthreads();
        if (F.tid < 128) { float s = 0.f;
#pragma unroll
            for (int w = 0; w < 8; ++w) s += red[w * 128 + F.tid];
            KM[(size_t)bn * D + h * 128 + F.tid] = s * (1.0f / 256.0f); }
        __syncthreads();
    }
}
__device__ __forceinline__ void l1_moba_naive(Frame& F, const Args& a) {
    const bf16* Qb = (const bf16*)(F.ws + R_Q); const bf16* Kb = (const bf16*)(F.ws + R_K); const bf16* Vb = (const bf16*)(F.ws + R_V); bf16* ATT = (bf16*)(F.ws + R_ATT);
    const float* KM = (const float*)(F.ws + WS_KM);
    const int gw = blockIdx.x * NWAVES + F.wave, NGW = F.G * NWAVES, lane = F.lane;
    LAS float* blut = (LAS float*)F.lds;
    fill_blut(blut, a.in[2], F.tid);
    __syncthreads();
    LAS float* qs = (LAS float*)(F.lds + 4096 + F.wave * 4608); LAS float* Ss = qs + 128;
    const float scale = 0.08838834764831845f;
    for (int task = gw; task < 8 * M; task += NGW) {
        const int tok = task >> 3, h = task & 7, b = tok >> 13, t = tok & (SEQ - 1), qblk = t >> 8;
        { const unsigned w = *(const GAS unsigned*)(Qb + (size_t)tok * D + h * 128 + 2 * lane); qs[2 * lane] = bflo(w); qs[2 * lane + 1] = bfhi(w); }
        LDS_WAIT();
        int sel[4] = {-1, -1, -1, qblk};
        if (qblk > 0) {
            float gs = -INFINITY;
            if (lane < qblk) { const GAS f32x4* km = (const GAS f32x4*)(KM + (size_t)(b * 32 + lane) * D + h * 128); float acc = 0.f;
                for (int c = 0; c < 32; ++c) { const f32x4 kv = km[c]; const f32x4 qv = *(const LAS f32x4*)(qs + 4 * c); acc += (qv.x * kv.x + qv.y * kv.y) + (qv.z * kv.z + qv.w * kv.w); }
                gs = acc; }
            const int nsel = qblk < 3 ? qblk : 3;
#pragma unroll
            for (int r = 0; r < 3; ++r) if (r < nsel) { const float mx = wave_max(gs); const unsigned long long bal = __ballot(gs == mx); const int idx = __ffsll((long long)bal) - 1; sel[r] = idx; if (lane == idx) gs = -INFINITY; }
        }
#pragma unroll
        for (int slot = 0; slot < 4; ++slot) {
            const int blk = sel[slot];
            if (blk < 0) {
#pragma unroll
                for (int tile = 0; tile < 4; ++tile) Ss[slot * 256 + tile * 64 + lane] = -INFINITY;
            } else {
#pragma unroll 1
                for (int tile = 0; tile < 4; ++tile) { const int kp = blk * 256 + tile * 64 + lane;
                    const GAS v4u* kr = (const GAS v4u*)(Kb + (size_t)(b * SEQ + kp) * D + h * 128); float acc = 0.f;
#pragma unroll 4
                    for (int c = 0; c < 16; ++c) { const v4u kw = kr[c]; const f32x4 qa = *(const LAS f32x4*)(qs + 8 * c), qb = *(const LAS f32x4*)(qs + 8 * c + 4);
                        acc += (qa.x * bflo(kw.x) + qa.y * bfhi(kw.x)) + (qa.z * bflo(kw.y) + qa.w * bfhi(kw.y)) + (qb.x * bflo(kw.z) + qb.y * bfhi(kw.z)) + (qb.z * bflo(kw.w) + qb.w * bfhi(kw.w)); }
                    const int dist = t - kp;
                    Ss[slot * 256 + tile * 64 + lane] = dist >= 0 ? acc * scale + blut[h * 128 + (dist > 127 ? 127 : dist)] : -INFINITY; }
            }
        }
        LDS_WAIT();
        float mx = -INFINITY;
#pragma unroll
        for (int i = 0; i < 16; ++i) mx = fmaxf(mx, Ss[i * 64 + lane]);
        mx = wave_max(mx);
        float sum = 0.f;
#pragma unroll
        for (int i = 0; i < 16; ++i) { const float p = __expf(Ss[i * 64 + lane] - mx); Ss[i * 64 + lane] = p; sum += p; }
        sum = wave_sum(sum);
        const float inv = 1.0f / sum;
        LDS_WAIT();
        float o0 = 0.f, o1 = 0.f;
#pragma unroll
        for (int slot = 0; slot < 4; ++slot) {
            const int blk = sel[slot];
            if (blk >= 0) {
                const bf16* vb = Vb + (size_t)(b * SEQ + blk * 256) * D + h * 128 + 2 * lane;
                const int nk = slot == 3 ? ((t - blk * 256 + 4) & ~3) : 256;
                for (int j = 0; j < nk; j += 4) { const f32x4 p4 = *(const LAS f32x4*)(Ss + slot * 256 + j);
                    const unsigned w0 = *(const GAS unsigned*)(vb + (size_t)(j + 0) * D), w1 = *(const GAS unsigned*)(vb + (size_t)(j + 1) * D), w2 = *(const GAS unsigned*)(vb + (size_t)(j + 2) * D), w3 = *(const GAS unsigned*)(vb + (size_t)(j + 3) * D);
                    o0 += p4.x * bflo(w0) + p4.y * bflo(w1) + p4.z * bflo(w2) + p4.w * bflo(w3);
                    o1 += p4.x * bfhi(w0) + p4.y * bfhi(w1) + p4.z * bfhi(w2) + p4.w * bfhi(w3); }
            }
        }
        *(GAS unsigned*)(ATT + (size_t)tok * D + h * 128 + 2 * lane) = pk2(o0 * inv, o1 * inv);
        LDS_WAIT();
    }
}

__device__ __forceinline__ void l1_route(Frame& F, const Args& a) {
    LAS float* WrL = (LAS float*)F.lds;
    LAS int* lcnt = (LAS int*)(F.lds + 32768);
    LAS int* lbase = lcnt + 8;
    LAS int* tiE = lcnt + 16;
    LAS int* tiL = tiE + 128;
    LAS float* tiW = (LAS float*)(tiL + 128);
    LAS float* tiR = tiW + 128;
    const float* router = a.in[20]; const float* gain = a.in[19];
    for (int i = F.tid; i < 8192; i += NWAVES * 64) WrL[i] = router[i] * gain[i >> 3];
    unsigned* gcnt = (unsigned*)(F.ctl + CW_ECNT);
    int* tok_e = (int*)(F.ws + WS_TOKE); float* gw_e = (float*)(F.ws + WS_GWE); float* rs_e = (float*)(F.ws + WS_RSE); int* pos = (int*)(F.ws + WS_POS);
    for (int chunk = blockIdx.x; chunk < M / 64; chunk += F.G) {
        if (F.tid < 8) lcnt[F.tid] = 0;
        __syncthreads();
        for (int tt = F.wave; tt < 64; tt += NWAVES) {
            const int tok = chunk * 64 + tt;
            const GAS f32x4* hr = (const GAS f32x4*)(F.H + (size_t)tok * D) + F.lane;
            float lg[8]; float ss = 0.f;
#pragma unroll
            for (int e = 0; e < 8; ++e) lg[e] = 0.f;
#pragma unroll
            for (int j = 0; j < 4; ++j) { const f32x4 hv = hr[64 * j]; const float hx[4] = {hv.x, hv.y, hv.z, hv.w};
#pragma unroll
                for (int q = 0; q < 4; ++q) { const int k = j * 256 + F.lane * 4 + q; const f32x4 wa = *(const LAS f32x4*)(WrL + k * 8), wb = *(const LAS f32x4*)(WrL + k * 8 + 4);
                    ss += hx[q] * hx[q];
                    lg[0] += hx[q] * wa.x; lg[1] += hx[q] * wa.y; lg[2] += hx[q] * wa.z; lg[3] += hx[q] * wa.w; lg[4] += hx[q] * wb.x; lg[5] += hx[q] * wb.y; lg[6] += hx[q] * wb.z; lg[7] += hx[q] * wb.w; } }
            ss = wave_sum(ss);
#pragma unroll
            for (int e = 0; e < 8; ++e) lg[e] = wave_sum(lg[e]);
            const float rs = rsqrtf(ss * (1.0f / 1024.0f) + EPS);
            float v0 = lg[0]; int e0 = 0;
#pragma unroll
            for (int e = 1; e < 8; ++e) if (lg[e] > v0) { v0 = lg[e]; e0 = e; }
            float v1 = -INFINITY; int e1 = 0;
#pragma unroll
            for (int e = 0; e < 8; ++e) if (e != e0 && lg[e] > v1) { v1 = lg[e]; e1 = e; }
            const float w0 = 1.0f / (1.0f + __expf((v1 - v0) * rs)), w1 = 1.0f - w0;
            if (F.lane == 0) { const int l0 = __hip_atomic_fetch_add(&lcnt[e0], 1, __ATOMIC_RELAXED, __HIP_MEMORY_SCOPE_WORKGROUP), l1 = __hip_atomic_fetch_add(&lcnt[e1], 1, __ATOMIC_RELAXED, __HIP_MEMORY_SCOPE_WORKGROUP);
                tiE[2 * tt] = e0; tiE[2 * tt + 1] = e1; tiL[2 * tt] = l0; tiL[2 * tt + 1] = l1; tiW[2 * tt] = w0; tiW[2 * tt + 1] = w1; tiR[tt] = rs; }
        }
        __syncthreads();
        if (F.tid < 8) lbase[F.tid] = (int)__hip_atomic_fetch_add(gcnt + F.tid, (unsigned)lcnt[F.tid], __ATOMIC_RELAXED, __HIP_MEMORY_SCOPE_AGENT);
        __syncthreads();
        if (F.tid < 128) { const int tt = F.tid >> 1, e = tiE[F.tid], idx = lbase[e] + tiL[F.tid], tok = chunk * 64 + tt;
            if (idx < 16384) { tok_e[e * 16384 + idx] = tok; gw_e[e * 16384 + idx] = tiW[F.tid]; rs_e[e * 16384 + idx] = tiR[tt]; }
            pos[2 * tok + (F.tid & 1)] = (e << 16) | idx; }
        __syncthreads();
    }
}
__device__ __forceinline__ void l1_combine(Frame& F, const Args& a) {
    const int gw = blockIdx.x * NWAVES + F.wave, NGW = F.G * NWAVES;
    const int* cntp = (const int*)(F.ctl + CW_ECNT); const int* pos = (const int*)(F.ws + WS_POS);
    pg8::MoeTiles T; T.init(cntp);
    const bf16* Y = (const bf16*)(F.ws + R_Y); bf16* XB = (bf16*)(F.ws + WS_XBA); float* ssq = (float*)(F.ws + WS_SSQA);
    for (int tok = gw; tok < M; tok += NGW) {
        const int p0 = pos[2 * tok], p1 = pos[2 * tok + 1];
        const int b0 = T.base_of(p0 >> 16), b1 = T.base_of(p1 >> 16);
        const size_t r0 = (size_t)b0 * 256 + (p0 & 0xffff), r1 = (size_t)b1 * 256 + (p1 & 0xffff);
        GAS f32x4* hr = (GAS f32x4*)(F.H + (size_t)tok * D) + F.lane;
        const GAS v2u* y0 = (const GAS v2u*)(Y + r0 * D) + F.lane; const GAS v2u* y1 = (const GAS v2u*)(Y + r1 * D) + F.lane;
        GAS v2u* xo = (GAS v2u*)(XB + (size_t)tok * D) + F.lane;
        float s = 0.f;
#pragma unroll
        for (int j = 0; j < 4; ++j) { f32x4 h = hr[64 * j]; const v2u a0 = y0[64 * j], a1 = y1[64 * j];
            h.x += bflo(a0.x) + bflo(a1.x); h.y += bfhi(a0.x) + bfhi(a1.x); h.z += bflo(a0.y) + bflo(a1.y); h.w += bfhi(a0.y) + bfhi(a1.y);
            hr[64 * j] = h; v2u w; w.x = pk2(h.x, h.y); w.y = pk2(h.z, h.w); xo[64 * j] = w;
            s += (h.x * h.x + h.y * h.y) + (h.z * h.z + h.w * h.w); }
        s = wave_sum(s);
        if (F.lane == 0) *(GAS f32x4*)(ssq + 4 * (size_t)tok) = (f32x4){s, 0.f, 0.f, 0.f};
    }
    cvt_f32_bf16_flat(a.in[1] + (size_t)M * PLE, (bf16*)(F.ws + R_PB1), (size_t)M * PLE / 8, blockIdx.x * (NWAVES * 64) + F.tid, F.G * NWAVES * 64);
}
__device__ __forceinline__ void final_norm(Frame& F, const Args& a) {
    const int gw = blockIdx.x * NWAVES + F.wave, NGW = F.G * NWAVES;
    const float* ssq = (const float*)(F.ws + WS_SSQB); const float* g = a.in[3];
    f32x4 gv[4];
#pragma unroll
    for (int j = 0; j < 4; ++j) gv[j] = ((const GAS f32x4*)g)[64 * j + F.lane];
    for (int tok = gw; tok < M; tok += NGW) {
        const float rs = pg8::rstd_of(ssq, tok);
        GAS f32x4* hr = (GAS f32x4*)(F.H + (size_t)tok * D) + F.lane;
#pragma unroll
        for (int j = 0; j < 4; ++j) { f32x4 h = hr[64 * j]; h = h * rs * gv[j]; hr[64 * j] = h; }
    }
}

constexpr int N_PHASES = 17;
__global__ void __launch_bounds__(NWAVES * 64, 2) trunk_fwd(Args args) {
    extern __shared__ __attribute__((aligned(16))) unsigned char lds[];
    Frame F;
    F.lds = (LAS unsigned char*)lds;
    F.MISC = (volatile LAS unsigned*)(F.lds + MISC_OFF);
    F.tid = threadIdx.x; F.lane = F.tid & 63; F.wave = __builtin_amdgcn_readfirstlane(F.tid >> 6);
    F.G = gridDim.x;
    F.ws = args.ws; F.ctl = (gu32*)(args.ws + WS_CTL); F.H = args.out;
    unsigned char* ws = args.ws;
    for (int u = F.tid; u < (LDS_BYTES - LDSCTL_OFF) / 4; u += NWAVES * 64) ((LAS unsigned*)(F.lds + LDSCTL_OFF))[u] = 0u;
    __syncthreads();
    XcdBarrier bar; bar.bar = (unsigned*)(F.ctl + CW_BAR); bar.x = 0; bar.st = nullptr;
    const int lo = args.ph_lo, hi = args.ph_hi;
    if (hi - lo > 1) bar = xcd_barrier_post((unsigned*)(F.ctl + CW_BAR), F.MISC + 8);
#define IN(k) (lo <= (k) && (k) < hi)
#define SEAM(k) do { if (IN(k) && IN((k) + 1)) xcd_barrier(bar); } while (0)
    const int bx = (int)blockIdx.x;
    float* SSQA = (float*)(ws + WS_SSQA); float* SSQB = (float*)(ws + WS_SSQB);
    bf16* XBA = (bf16*)(ws + WS_XBA); bf16* XBB = (bf16*)(ws + R_XBB);

    if (IN(0)) { p0_prologue(F, args); } SEAM(0);
    if (IN(1)) { pg8::Gemm g{XBA, (const bf16*)(ws + W_IN), D, 0}; pg8::StaticOrder S; S.init(M, DIN0, F.G, bx);
        pg8::EpiScaleBf16 E{(bf16*)(ws + R_Z), DIN0, SSQA, 0, 0};
        pg8::gemm_phase<pg8::EpiScaleBf16, pg8::StaticOrder, true, true, false>(F.lds, g, S, E); } SEAM(1);
    if (IN(2)) { l0_mixer_naive(F, args); } SEAM(2);
    if (IN(3)) { pg8::Gemm g{(const bf16*)(ws + R_MIX), (const bf16*)(ws + W_OUT), D, 0}; pg8::StaticOrder S; S.init(M, D, F.G, bx);
        pg8::EpiRes<false> E{args.in[0], F.H, XBA, SSQB, nullptr, nullptr};
        pg8::gemm_phase<pg8::EpiRes<false>, pg8::StaticOrder, false, true, false>(F.lds, g, S, E); } SEAM(3);
    if (IN(4)) { pg8::Gemm g{XBA, (const bf16*)(ws + W_GU0), D, 0}; pg8::StaticOrder S; S.init(M, 2 * DFF0, F.G, bx);
        pg8::EpiSwiGLU<false> E{(bf16*)(ws + R_HM0), DFF0, SSQB};
        pg8::gemm_phase<pg8::EpiSwiGLU<false>, pg8::StaticOrder, true, true, false>(F.lds, g, S, E); } SEAM(4);
    if (IN(5)) { pg8::Gemm g{(const bf16*)(ws + R_HM0), (const bf16*)(ws + W_D0), DFF0, 0}; pg8::StaticOrder S; S.init(M, D, F.G, bx);
        pg8::EpiRes<false> E{F.H, F.H, XBA, SSQA, nullptr, nullptr};
        pg8::gemm_phase<pg8::EpiRes<false>, pg8::StaticOrder, false, true, false>(F.lds, g, S, E); } SEAM(5);
    if (IN(6)) {
        { pg8::Gemm g{(const bf16*)(ws + R_PB0), (const bf16*)(ws + W_PP0), PLE, 0}; pg8::StaticOrder S; S.init(M, D, F.G, bx);
          pg8::EpiPP E{(bf16*)(ws + R_PP)};
          pg8::gemm_phase<pg8::EpiPP, pg8::StaticOrder, false, true, false>(F.lds, g, S, E); }
        { pg8::Gemm g{XBA, (const bf16*)(ws + W_PG0), D, 0}; pg8::StaticOrder S; S.init(M, D, F.G, bx);
          pg8::EpiRes<true> E{F.H, F.H, XBB, SSQB, SSQA, (const bf16*)(ws + R_PP)};
          pg8::gemm_phase<pg8::EpiRes<true>, pg8::StaticOrder, false, true, false>(F.lds, g, S, E); }
    } SEAM(6);
    if (IN(7)) { pg8::Gemm g{XBB, (const bf16*)(ws + W_QKV), D, 0}; pg8::StaticOrder S; S.init(M, 3 * D, F.G, bx);
        pg8::EpiScaleBf16 E{(bf16*)(ws + R_Q), D, SSQB, D, (size_t)(R_K - R_Q) / 2};
        pg8::gemm_phase<pg8::EpiScaleBf16, pg8::StaticOrder, true, true, false>(F.lds, g, S, E); } SEAM(7);
    if (IN(8)) { l1_kmean(F); } SEAM(8);
    if (IN(9)) { l1_moba_naive(F, args); } SEAM(9);
    if (IN(10)) { pg8::Gemm g{(const bf16*)(ws + R_ATT), (const bf16*)(ws + W_O), D, 0}; pg8::StaticOrder S; S.init(M, D, F.G, bx);
        pg8::EpiRes<false> E{F.H, F.H, XBA, nullptr, nullptr, nullptr};
        pg8::gemm_phase<pg8::EpiRes<false>, pg8::StaticOrder, false, true, false>(F.lds, g, S, E); } SEAM(10);
    if (IN(11)) { l1_route(F, args); } SEAM(11);
    if (IN(12)) { pg8::Gemm g{XBA, (const bf16*)(ws + W_EGU), D, (size_t)2 * DFE * D}; pg8::MoeOrder S; S.init((const int*)(F.ctl + CW_ECNT), 2 * DFE / 256, F.G, bx, (const int*)(ws + WS_TOKE));
        pg8::EpiSwiGLU<true> E{(bf16*)(ws + R_HMG), DFE, (const float*)(ws + WS_RSE)};
        pg8::gemm_phase<pg8::EpiSwiGLU<true>, pg8::MoeOrder, true, true, true>(F.lds, g, S, E); } SEAM(12);
    if (IN(13)) { pg8::Gemm g{(const bf16*)(ws + R_HMG), (const bf16*)(ws + W_ED), DFE, (size_t)D * DFE}; pg8::MoeOrder S; S.init((const int*)(F.ctl + CW_ECNT), D / 256, F.G, bx, nullptr);
        pg8::EpiMoeDown E{(bf16*)(ws + R_Y), (const float*)(ws + WS_GWE)};
        pg8::gemm_phase<pg8::EpiMoeDown, pg8::MoeOrder, true, true, false>(F.lds, g, S, E); } SEAM(13);
    if (IN(14)) { l1_combine(F, args); } SEAM(14);
    if (IN(15)) {
        { pg8::Gemm g{(const bf16*)(ws + R_PB1), (const bf16*)(ws + W_PP1), PLE, 0}; pg8::StaticOrder S; S.init(M, D, F.G, bx);
          pg8::EpiPP E{(bf16*)(ws + R_PP1)};
          pg8::gemm_phase<pg8::EpiPP, pg8::StaticOrder, false, true, false>(F.lds, g, S, E); }
        { pg8::Gemm g{XBA, (const bf16*)(ws + W_PG1), D, 0}; pg8::StaticOrder S; S.init(M, D, F.G, bx);
          pg8::EpiRes<true> E{F.H, F.H, nullptr, SSQB, SSQA, (const bf16*)(ws + R_PP1)};
          pg8::gemm_phase<pg8::EpiRes<true>, pg8::StaticOrder, false, true, false>(F.lds, g, S, E); }
    } SEAM(15);
    if (IN(16)) { final_norm(F, args); }
#undef IN
#undef SEAM
}

extern "C" void kernel_launch(void* const* d_in, const int* in_sizes, int n_in, void* d_out, int out_size, void* d_ws, size_t ws_size, hipStream_t stream) {
    static int grid = 0;
    if (grid == 0) {
        if (n_in != 27 || in_sizes[0] != M * D || out_size != M * D || ws_size < WS_END) { fprintf(stderr, "kernel_launch: unexpected problem (n_in %d, in0 %d, out %d, ws %zu < %zu); nothing launched\n", n_in, n_in > 0 ? in_sizes[0] : -1, out_size, ws_size, (size_t)WS_END); grid = -1; return; }
        int dev = 0, cus = 0, per_cu = 0;
        if (hipGetDevice(&dev) != hipSuccess || hipDeviceGetAttribute(&cus, hipDeviceAttributeMultiprocessorCount, dev) != hipSuccess) { grid = -1; return; }
        if (hipFuncSetAttribute((const void*)trunk_fwd, hipFuncAttributeMaxDynamicSharedMemorySize, LDS_BYTES) != hipSuccess) { fprintf(stderr, "kernel_launch: hipFuncSetAttribute failed\n"); grid = -1; return; }
        if (hipOccupancyMaxActiveBlocksPerMultiprocessor(&per_cu, (const void*)trunk_fwd, NWAVES * 64, LDS_BYTES) != hipSuccess || per_cu < 1) fprintf(stderr, "kernel_launch: occupancy query reports %d\n", per_cu);
        (void)hipGetLastError();
        grid = cus;
        if (grid != 256) { fprintf(stderr, "kernel_launch: built for 256 CUs, found %d; nothing launched\n", cus); grid = -1; return; }
    }
    if (grid < 0) return;
    if (hipMemsetAsync((char*)d_ws + WS_CTL, 0, CTL_ZERO_BYTES, stream) != hipSuccess) return;
    Args a{};
    for (int i = 0; i < 27; ++i) a.in[i] = (const float*)d_in[i];
    a.out = (float*)d_out; a.ws = (unsigned char*)d_ws;
#if MK_ONE_LAUNCH
    a.ph_lo = 0; a.ph_hi = N_PHASES;
    hipLaunchKernelGGL(trunk_fwd, dim3(grid), dim3(NWAVES * 64), LDS_BYTES, stream, a);
#else
    for (int ph = 0; ph < N_PHASES; ++ph) { a.ph_lo = ph; a.ph_hi = ph + 1; hipLaunchKernelGGL(trunk_fwd, dim3(grid), dim3(NWAVES * 64), LDS_BYTES, stream, a); }
#endif
}
```

```cpp
#include <hip/hip_runtime.h>
#include <cstdio>
#include <cstdint>

#ifndef MK_ONE_LAUNCH
#define MK_ONE_LAUNCH 1
#endif

namespace pg8 {
#define PG8_LAS __attribute__((address_space(3)))
typedef unsigned short bf16_t;
typedef short bf16x8 __attribute__((ext_vector_type(8)));
typedef float f32x4 __attribute__((ext_vector_type(4)));
typedef float f32x2 __attribute__((ext_vector_type(2)));
typedef unsigned u32x4 __attribute__((ext_vector_type(4)));
typedef unsigned u32x2 __attribute__((ext_vector_type(2)));
constexpr int BM = 256, BK = 64, HALF = 128, HTB = HALF * BK * 2, STAGE_BYTES = 8 * HTB, NXCD = 8, WGM = 8;

__host__ __device__ __forceinline__ int lds_byte(int r, int c) { const int st = (r >> 4) * 2 + (c >> 5), rr = r & 15, cc = c & 31, ob = rr * 64 + cc * 2; return st * 1024 + (ob ^ (((ob >> 9) & 1) << 5)); }
__host__ __device__ __forceinline__ void stage_rc(int b, int& R, int& C) { const int st = b / 1024, sb = b % 1024, swz = sb ^ (((sb >> 9) & 1) << 5); R = (st >> 1) * 16 + swz / 64; C = (st & 1) * 32 + (swz % 64) / 2; }
__host__ __device__ __forceinline__ int perm32(int rho) { const int n = rho >> 4, i = rho & 15; return 8 * (i >> 2) + 4 * n + (i & 3); }

struct Unit { int pm, pn, e, mt, nv; };
struct Gemm { const bf16_t* A; const bf16_t* Bt; int K; size_t bslab; };

__device__ __forceinline__ void map_tile(int L, int nwg, int nM, int nN, int& pm, int& pn) {
    int wgid = L; { const int q = nwg / NXCD, r = nwg % NXCD, xcd = wgid % NXCD, off = wgid / NXCD; wgid = (xcd < r ? xcd * (q + 1) : r * (q + 1) + (xcd - r) * q) + off; }
    const int nig = WGM * nN, gid = wgid / nig, fm = gid * WGM, gsz = (nM - fm) < WGM ? (nM - fm) : WGM;
    pm = fm + ((wgid % nig) % gsz); pn = (wgid % nig) / gsz;
}
struct StaticOrder {
    int nM, nN, nwg, G, c;
    __device__ __forceinline__ void init(int M, int N, int G_, int c_) { nM = M / BM; nN = N / BM; nwg = nM * nN; G = G_; c = c_; }
    __device__ __forceinline__ bool next(int i, Unit& u) const {
        const long L = (long)i * G + c; if (L >= nwg) return false;
        map_tile((int)L, nwg, nM, nN, u.pm, u.pn); u.e = 0; u.mt = u.pm; u.nv = 256; return true;
    }
    __device__ __forceinline__ int arow(const Unit& u, int r) const { return u.pm * BM + r; }
};
struct MoeTiles {
    int c0, c1, c2, c3, c4, c5, c6, c7, t1, t2, t3, t4, t5, t6, t7, t8;
    __device__ __forceinline__ static int clampc(int v) { return v < 0 ? 0 : (v > 16384 ? 16384 : v); }
    __device__ __forceinline__ void init(const int* cntp) {
        c0 = clampc(cntp[0]); c1 = clampc(cntp[1]); c2 = clampc(cntp[2]); c3 = clampc(cntp[3]); c4 = clampc(cntp[4]); c5 = clampc(cntp[5]); c6 = clampc(cntp[6]); c7 = clampc(cntp[7]);
        t1 = (c0 + 255) >> 8; t2 = t1 + ((c1 + 255) >> 8); t3 = t2 + ((c2 + 255) >> 8); t4 = t3 + ((c3 + 255) >> 8); t5 = t4 + ((c4 + 255) >> 8); t6 = t5 + ((c5 + 255) >> 8); t7 = t6 + ((c6 + 255) >> 8); t8 = t7 + ((c7 + 255) >> 8);
    }
    __device__ __forceinline__ int base_of(int e) const { return e == 0 ? 0 : e == 1 ? t1 : e == 2 ? t2 : e == 3 ? t3 : e == 4 ? t4 : e == 5 ? t5 : e == 6 ? t6 : t7; }
    __device__ __forceinline__ int cnt_of(int e) const { return e == 0 ? c0 : e == 1 ? c1 : e == 2 ? c2 : e == 3 ? c3 : e == 4 ? c4 : e == 5 ? c5 : e == 6 ? c6 : c7; }
    __device__ __forceinline__ int expert_of(int pm) const { return (pm >= t1) + (pm >= t2) + (pm >= t3) + (pm >= t4) + (pm >= t5) + (pm >= t6) + (pm >= t7); }
};
struct MoeOrder {
    MoeTiles T; int nN, nwg, G, c; const int* tok;
    __device__ __forceinline__ void init(const int* cntp, int nN_, int G_, int c_, const int* tok_) { T.init(cntp); nN = nN_; nwg = T.t8 * nN_; G = G_; c = c_; tok = tok_; }
    __device__ __forceinline__ bool next(int i, Unit& u) const {
        const long L = (long)i * G + c; if (L >= nwg) return false;
        map_tile((int)L, nwg, T.t8, nN, u.pm, u.pn);
        const int e = T.expert_of(u.pm);
        u.e = e; u.mt = u.pm - T.base_of(e); const int rem = T.cnt_of(e) - u.mt * 256; u.nv = rem > 256 ? 256 : rem; return true;
    }
    __device__ __forceinline__ int arow(const Unit& u, int r) const { return r < u.nv ? tok[u.e * 16384 + u.mt * 256 + r] : 0; }
};

__device__ __forceinline__ unsigned cvt_pk_bf16(float lo, float hi) { unsigned r; asm volatile("v_cvt_pk_bf16_f32 %0, %1, %2" : "=v"(r) : "v"(lo), "v"(hi)); return r; }
__device__ __forceinline__ float rstd_of(const float* ssq4, int row) { const f32x4 s = *(const f32x4*)(ssq4 + 4 * (size_t)row); return rsqrtf(((s[0] + s[1]) + (s[2] + s[3])) * (1.0f / 1024.0f) + 1e-6f); }
__device__ __forceinline__ float rstd_from(const f32x4 s) { return rsqrtf(((s[0] + s[1]) + (s[2] + s[3])) * (1.0f / 1024.0f) + 1e-6f); }
__device__ __forceinline__ float silu_f(float x) { return x * __builtin_amdgcn_rcpf(1.0f + __expf(-x)); }
__device__ __forceinline__ float sigmoid_f(float x) { return __builtin_amdgcn_rcpf(1.0f + __expf(-x)); }

struct EpiScaleBf16 {
    static constexpr bool PERM = true, AFTER_DRAIN = false;
    bf16_t* O; int ldc; const float* ssq4; int split_cols; size_t split_stride; int sc_lo, sc_hi; float scale0;
    __device__ __forceinline__ void operator()(const f32x4 (&acc)[2][2][4][2], const Unit& u, int wr, int wc, int fr, int fq) const {
        const int row0 = u.pm * BM + wr * 64 + fr; int colt = u.pn * BM; bf16_t* base = O; const float sc = (u.pn >= sc_lo && u.pn < sc_hi) ? scale0 : 1.f;
        if (split_cols) { const int t = colt / split_cols; base += (size_t)t * split_stride; colt -= t * split_cols; }
        const int col0 = colt + wc * 32 + 8 * fq;
        f32x4 sq[2][4];
#pragma unroll
        for (int ai = 0; ai < 2; ++ai)
#pragma unroll
            for (int m = 0; m < 4; ++m) sq[ai][m] = *(const f32x4*)(ssq4 + 4 * (size_t)(row0 + ai * HALF + m * 16));
#pragma unroll
        for (int ai = 0; ai < 2; ++ai)
#pragma unroll
            for (int m = 0; m < 4; ++m) { const int row = row0 + ai * HALF + m * 16; const float rs = rstd_from(sq[ai][m]) * sc; bf16_t* rowp = base + (size_t)row * ldc + col0;
#pragma unroll
                for (int bj = 0; bj < 2; ++bj) { const f32x4 v0 = acc[ai][bj][m][0] * rs, v1 = acc[ai][bj][m][1] * rs;
                    u32x4 w; w.x = cvt_pk_bf16(v0[0], v0[1]); w.y = cvt_pk_bf16(v0[2], v0[3]); w.z = cvt_pk_bf16(v1[0], v1[1]); w.w = cvt_pk_bf16(v1[2], v1[3]);
                    *(u32x4*)(rowp + bj * HALF) = w; } }
    }
};
template <bool MOE> struct EpiSwiGLU {
    static constexpr bool PERM = true, AFTER_DRAIN = false;
    bf16_t* O; int ldo; const float* rs_src;
    __device__ __forceinline__ void operator()(const f32x4 (&acc)[2][2][4][2], const Unit& u, int wr, int wc, int fr, int fq) const {
        const int col0 = u.pn * HALF + wc * 32 + 8 * fq;
        float rsv[2][4];
#pragma unroll
        for (int ai = 0; ai < 2; ++ai)
#pragma unroll
            for (int m = 0; m < 4; ++m) { const int rl = ai * HALF + wr * 64 + m * 16 + fr;
                if (MOE) rsv[ai][m] = rl < u.nv ? rs_src[u.e * 16384 + u.mt * 256 + rl] : 0.f;
                else { const f32x4 s = *(const f32x4*)(rs_src + 4 * (size_t)(u.pm * BM + rl)); rsv[ai][m] = ((s[0] + s[1]) + (s[2] + s[3])); } }
#pragma unroll
        for (int ai = 0; ai < 2; ++ai)
#pragma unroll
            for (int m = 0; m < 4; ++m) { const int rl = ai * HALF + wr * 64 + m * 16 + fr; const int row = u.pm * BM + rl;
                const float rs = MOE ? rsv[ai][m] : rsqrtf(rsv[ai][m] * (1.0f / 1024.0f) + 1e-6f);
                const f32x4 g0 = acc[ai][0][m][0] * rs, g1 = acc[ai][0][m][1] * rs, u0 = acc[ai][1][m][0] * rs, u1 = acc[ai][1][m][1] * rs;
                u32x4 w;
                w.x = cvt_pk_bf16(silu_f(g0[0]) * u0[0], silu_f(g0[1]) * u0[1]); w.y = cvt_pk_bf16(silu_f(g0[2]) * u0[2], silu_f(g0[3]) * u0[3]);
                w.z = cvt_pk_bf16(silu_f(g1[0]) * u1[0], silu_f(g1[1]) * u1[1]); w.w = cvt_pk_bf16(silu_f(g1[2]) * u1[2], silu_f(g1[3]) * u1[3]);
                *(u32x4*)(O + (size_t)row * ldo + col0) = w; }
    }
};
struct EpiMoeDown {
    static constexpr bool PERM = true, AFTER_DRAIN = false;
    bf16_t* Y; const float* gw;
    __device__ __forceinline__ void operator()(const f32x4 (&acc)[2][2][4][2], const Unit& u, int wr, int wc, int fr, int fq) const {
        const int col0 = u.pn * BM + wc * 32 + 8 * fq;
        float gv[2][4];
#pragma unroll
        for (int ai = 0; ai < 2; ++ai)
#pragma unroll
            for (int m = 0; m < 4; ++m) { const int rl = ai * HALF + wr * 64 + m * 16 + fr; gv[ai][m] = rl < u.nv ? gw[u.e * 16384 + u.mt * 256 + rl] : 0.f; }
#pragma unroll
        for (int ai = 0; ai < 2; ++ai)
#pragma unroll
            for (int m = 0; m < 4; ++m) { const int rl = ai * HALF + wr * 64 + m * 16 + fr; const int row = u.pm * BM + rl;
                const float g = gv[ai][m];
#pragma unroll
                for (int bj = 0; bj < 2; ++bj) { const f32x4 v0 = acc[ai][bj][m][0] * g, v1 = acc[ai][bj][m][1] * g;
                    u32x4 w; w.x = cvt_pk_bf16(v0[0], v0[1]); w.y = cvt_pk_bf16(v0[2], v0[3]); w.z = cvt_pk_bf16(v1[0], v1[1]); w.w = cvt_pk_bf16(v1[2], v1[3]);
                    *(u32x4*)(Y + (size_t)row * 1024 + col0 + bj * HALF) = w; } }
    }
};
struct EpiPP {
    static constexpr bool PERM = false, AFTER_DRAIN = false;
    bf16_t* O;
    __device__ __forceinline__ void operator()(const f32x4 (&acc)[2][2][4][2], const Unit& u, int wr, int wc, int fr, int fq) const {
        const int col0 = u.pn * BM + wc * 32 + 4 * fq;
#pragma unroll
        for (int ai = 0; ai < 2; ++ai)
#pragma unroll
            for (int m = 0; m < 4; ++m) { const size_t off = (size_t)(u.pm * BM + ai * HALF + wr * 64 + m * 16 + fr) * 1024 + col0;
#pragma unroll
                for (int bj = 0; bj < 2; ++bj)
#pragma unroll
                    for (int n = 0; n < 2; ++n) { const f32x4 v = acc[ai][bj][m][n]; u32x2 w; w.x = cvt_pk_bf16(v[0], v[1]); w.y = cvt_pk_bf16(v[2], v[3]); *(u32x2*)(O + off + bj * HALF + n * 16) = w; } }
    }
};
template <bool PLE> struct EpiRes {
    static constexpr bool PERM = false, AFTER_DRAIN = true;
    const float* Hin; float* Hout; bf16_t* XB; float* ssq_out; const float* ssq_in; const bf16_t* PP;
    __device__ __forceinline__ void fused(f32x4 (&acc)[2][2][4][2], const Unit& u, int wr, int wc, int fr, int fq, PG8_LAS unsigned char* lds, int wid, int lane) const {
        PG8_LAS float* P = (PG8_LAS float*)lds;
        const int col0 = u.pn * BM + wc * 32 + 4 * fq;
#pragma unroll
        for (int ai = 0; ai < 2; ++ai)
#pragma unroll
            for (int m = 0; m < 4; ++m) { const int rl = ai * HALF + wr * 64 + m * 16 + fr; const int row = u.pm * BM + rl; const size_t off = (size_t)row * 1024 + col0;
                float rs = 0.f; if (PLE) rs = rstd_of(ssq_in, row);
                float s = 0.f;
#pragma unroll
                for (int bj = 0; bj < 2; ++bj)
#pragma unroll
                    for (int n = 0; n < 2; ++n) { const size_t c = off + bj * HALF + n * 16; const f32x4 hin = *(const f32x4*)(Hin + c); f32x4 v = acc[ai][bj][m][n];
                        if (PLE) { const u32x2 pw = *(const u32x2*)(PP + c);
                            const float p0 = __uint_as_float(pw.x << 16), p1 = __uint_as_float(pw.x & 0xffff0000u), p2 = __uint_as_float(pw.y << 16), p3 = __uint_as_float(pw.y & 0xffff0000u);
                            v[0] = hin[0] + sigmoid_f(v[0] * rs) * p0; v[1] = hin[1] + sigmoid_f(v[1] * rs) * p1; v[2] = hin[2] + sigmoid_f(v[2] * rs) * p2; v[3] = hin[3] + sigmoid_f(v[3] * rs) * p3;
                        } else v = hin + v;
                        *(f32x4*)(Hout + c) = v;
                        if (XB) { u32x2 w; w.x = cvt_pk_bf16(v[0], v[1]); w.y = cvt_pk_bf16(v[2], v[3]); *(u32x2*)(XB + c) = w; }
                        s += (v[0] * v[0] + v[1] * v[1]) + (v[2] * v[2] + v[3] * v[3]); }
                s += __shfl_xor(s, 16); s += __shfl_xor(s, 32);
                if (ssq_out && fq == 0) P[rl * 4 + wc] = s;
                asm volatile("" ::: "memory"); }
        if (ssq_out) {
            asm volatile("s_waitcnt lgkmcnt(0)" ::: "memory"); __builtin_amdgcn_s_barrier(); asm volatile("" ::: "memory");
            const int t = wid * 64 + lane;
            if (t < 256) { const f32x4 q = *(const PG8_LAS f32x4*)(P + t * 4); ssq_out[(size_t)(u.pm * BM + t) * 4 + u.pn] = (q[0] + q[1]) + (q[2] + q[3]); }
            asm volatile("s_waitcnt lgkmcnt(0)" ::: "memory"); __builtin_amdgcn_s_barrier(); asm volatile("" ::: "memory");
        }
    }
};

template <class Epi, class Sched, bool ALIGN_EPI, bool SP2, bool GATHER>
__device__ __forceinline__ void gemm_phase(PG8_LAS unsigned char* lds, const Gemm g, const Sched& S, const Epi& E) {
    int tid_ = threadIdx.x; asm volatile("" : "+v"(tid_));
    const int tid = tid_, wid = __builtin_amdgcn_readfirstlane(tid >> 6), lane = tid & 63, wr = wid >> 2, wc = wid & 3, fr = lane & 15, fq = lane >> 4;
    const int K = g.K, nt = K / BK;
    unsigned voffA[2], voffB[2]; int aR[2], aC[2];
#pragma unroll
    for (int i = 0; i < 2; ++i) { int R, C; stage_rc(tid * 16 + i * 8192, R, C); const int Rb = Epi::PERM ? ((R & ~31) + perm32(R & 31)) : R;
        voffA[i] = (unsigned)(R * K + C) * 2u; voffB[i] = (unsigned)(Rb * K + C) * 2u; aR[i] = R; aC[i] = C; }
    const size_t kstep = (size_t)(BK * 2);
    const size_t hstep = (size_t)HALF * K * 2;
    const size_t tstep = 2 * hstep;
    const unsigned ldsw = (unsigned)wid * 1024u;
    const int aoff = lds_byte(wr * 64 + fr, fq * 8), boff = lds_byte(wc * 32 + fr, fq * 8);
    unsigned gcur[2][2], gnxt[2][2];
#define PG8_SA(b, h) (((b) * 2 + (h)) * HTB)
#define PG8_SB(b, h) ((4 + (b) * 2 + (h)) * HTB)
#define PG8_STAGE(bufoff, gbase, voff) do { _Pragma("unroll") for (int _i = 0; _i < 2; ++_i) \
        __builtin_amdgcn_global_load_lds((const unsigned*)((const char*)(gbase) + (voff)[_i]), (PG8_LAS unsigned*)(lds + (bufoff) + ldsw + _i * 8192), 16, 0, 0); } while (0)
#define PG8_STAGE_A(bufoff, p, h, NX) do { if constexpr (GATHER) { unsigned _vo[2]; _vo[0] = (NX) ? gnxt[h][0] : gcur[h][0]; _vo[1] = (NX) ? gnxt[h][1] : gcur[h][1]; PG8_STAGE(bufoff, p, _vo); } \
        else { PG8_STAGE(bufoff, (p) + (h) * hstep, voffA); } } while (0)
#define PG8_GOFF(dst, uu) do { _Pragma("unroll") for (int _h = 0; _h < 2; ++_h) _Pragma("unroll") for (int _i = 0; _i < 2; ++_i) \
        dst[_h][_i] = ((unsigned)S.arow(uu, _h * HALF + aR[_i]) * (unsigned)K + (unsigned)aC[_i]) * 2u; } while (0)
#define PG8_LDA(dst, b, h) do { _Pragma("unroll") for (int m = 0; m < 4; ++m) _Pragma("unroll") for (int k = 0; k < 2; ++k) dst[m][k] = *(const PG8_LAS bf16x8*)(lds + PG8_SA(b, h) + aoff + m * 2048 + k * 1024); } while (0)
#define PG8_LDB(dst, b, h) do { _Pragma("unroll") for (int n = 0; n < 2; ++n) _Pragma("unroll") for (int k = 0; k < 2; ++k) dst[n][k] = *(const PG8_LAS bf16x8*)(lds + PG8_SB(b, h) + boff + n * 2048 + k * 1024); } while (0)
#define PG8_MMA(ai, bj, At, Bt) do { __builtin_amdgcn_s_setprio(1); _Pragma("unroll") for (int m = 0; m < 4; ++m) _Pragma("unroll") for (int n = 0; n < 2; ++n) _Pragma("unroll") for (int k = 0; k < 2; ++k) \
        acc[ai][bj][m][n] = __builtin_amdgcn_mfma_f32_16x16x32_bf16(Bt[n][k], At[m][k], acc[ai][bj][m][n], 0, 0, 0); __builtin_amdgcn_s_setprio(0); } while (0)
#define PG8_WAIT_V(n) asm volatile("s_waitcnt vmcnt(" #n ")" ::: "memory")
#define PG8_WAIT_L(n) asm volatile("s_waitcnt lgkmcnt(" #n ")" ::: "memory")
#define PG8_BAR __builtin_amdgcn_s_barrier()
#define PG8_SCHED __builtin_amdgcn_sched_barrier(0)
    Unit cur, nxt; int ui = 0;
    if (!S.next(0, cur)) return;
    f32x4 acc[2][2][4][2];
#pragma unroll
    for (int a = 0; a < 2; ++a)
#pragma unroll
        for (int b = 0; b < 2; ++b)
#pragma unroll
            for (int m = 0; m < 4; ++m)
#pragma unroll
                for (int n = 0; n < 2; ++n) acc[a][b][m][n] = (f32x4){0.f, 0.f, 0.f, 0.f};
    bf16x8 At[4][2], B0[2][2], B1[2][2];
    const char* cA = GATHER ? (const char*)g.A : (const char*)g.A + (size_t)cur.pm * tstep;
    const char* cB = (const char*)g.Bt + ((size_t)cur.e * g.bslab) * 2 + (size_t)cur.pn * tstep;
    if constexpr (GATHER) { PG8_GOFF(gcur, cur); PG8_GOFF(gnxt, cur); }
    if constexpr (SP2) {
        PG8_STAGE(PG8_SB(0, 0), cB, voffB); PG8_STAGE(PG8_SB(0, 1), cB + hstep, voffB); PG8_STAGE_A(PG8_SA(0, 0), cA, 0, false); PG8_STAGE_A(PG8_SA(0, 1), cA, 1, false);
        if (wr == 1) PG8_BAR;
        PG8_WAIT_V(2); PG8_BAR;
        PG8_STAGE(PG8_SB(1, 0), cB + kstep, voffB); PG8_STAGE_A(PG8_SA(1, 0), cA + kstep, 0, false); PG8_STAGE(PG8_SB(1, 1), cB + hstep + kstep, voffB);
        PG8_WAIT_V(6); PG8_BAR;
    } else {
        PG8_STAGE(PG8_SB(0, 0), cB, voffB); PG8_STAGE_A(PG8_SA(0, 0), cA, 0, false); PG8_STAGE(PG8_SB(0, 1), cB + hstep, voffB); PG8_STAGE_A(PG8_SA(0, 1), cA, 1, false);
        if (wr == 1) PG8_BAR;
        PG8_WAIT_V(4); PG8_BAR;
        PG8_STAGE(PG8_SB(1, 0), cB + kstep, voffB); PG8_STAGE_A(PG8_SA(1, 0), cA + kstep, 0, false); PG8_STAGE(PG8_SB(1, 1), cB + hstep + kstep, voffB);
        PG8_WAIT_V(6); PG8_BAR;
    }
    for (;;) {
        const bool has_next = S.next(ui + 1, nxt);
        const char* nA = GATHER ? (const char*)g.A : (has_next ? (const char*)g.A + (size_t)nxt.pm * tstep : cA);
        const char* nB = has_next ? (const char*)g.Bt + ((size_t)nxt.e * g.bslab) * 2 + (size_t)nxt.pn * tstep : cB;
        if constexpr (GATHER) { if (has_next) { PG8_GOFF(gnxt, nxt); } else {
#pragma unroll
            for (int _h = 0; _h < 2; ++_h)
#pragma unroll
                for (int _i = 0; _i < 2; ++_i) gnxt[_h][_i] = gcur[_h][_i]; } }
        for (int t = 0; t < nt; t += 2) {
            const bool last = (t == nt - 2);
            const char* a1 = cA + (size_t)(t + 1) * kstep;
            const char* a2 = last ? nA : cA + (size_t)(t + 2) * kstep; const char* b2 = last ? nB : cB + (size_t)(t + 2) * kstep;
            const char* a3 = a2 + kstep; const char* b3 = b2 + kstep;
            if constexpr (SP2) {
            PG8_LDB(B0, 0, 0); PG8_LDB(B1, 0, 1); PG8_SCHED; PG8_LDA(At, 0, 0); PG8_STAGE_A(PG8_SA(1, 1), a1, 1, false);
            PG8_WAIT_V(8); PG8_WAIT_L(0); PG8_BAR; PG8_MMA(0, 0, At, B0); PG8_MMA(0, 1, At, B1); PG8_BAR; PG8_SCHED;
            PG8_LDA(At, 0, 1); PG8_STAGE(PG8_SB(0, 0), b2, voffB); PG8_STAGE(PG8_SB(0, 1), b2 + hstep, voffB); PG8_STAGE_A(PG8_SA(0, 0), a2, 0, last);
            PG8_WAIT_V(8); PG8_WAIT_L(0); PG8_BAR; PG8_MMA(1, 0, At, B0); PG8_MMA(1, 1, At, B1); PG8_BAR; PG8_SCHED;
            PG8_LDB(B0, 1, 0); PG8_LDB(B1, 1, 1); PG8_SCHED; PG8_LDA(At, 1, 0); PG8_STAGE_A(PG8_SA(0, 1), a2, 1, last);
            PG8_WAIT_V(8); PG8_WAIT_L(0); PG8_BAR; PG8_MMA(0, 0, At, B0); PG8_MMA(0, 1, At, B1); PG8_BAR; PG8_SCHED;
            PG8_LDA(At, 1, 1); PG8_STAGE(PG8_SB(1, 0), b3, voffB); PG8_STAGE(PG8_SB(1, 1), b3 + hstep, voffB); PG8_STAGE_A(PG8_SA(1, 0), a3, 0, last);
            PG8_WAIT_V(8); PG8_WAIT_L(0); PG8_BAR; PG8_MMA(1, 0, At, B0); PG8_MMA(1, 1, At, B1); PG8_BAR; PG8_SCHED;
            } else {
            PG8_LDB(B0, 0, 0); PG8_SCHED; PG8_LDA(At, 0, 0); PG8_STAGE_A(PG8_SA(1, 1), a1, 1, false);
            PG8_WAIT_L(8); PG8_BAR; PG8_WAIT_L(0); PG8_MMA(0, 0, At, B0); PG8_BAR; PG8_SCHED;
            PG8_LDB(B1, 0, 1); PG8_STAGE(PG8_SB(0, 0), b2, voffB);
            PG8_BAR; PG8_WAIT_L(0); PG8_MMA(0, 1, At, B1); PG8_BAR;
            PG8_LDA(At, 0, 1); PG8_STAGE_A(PG8_SA(0, 0), a2, 0, last);
            PG8_BAR; PG8_WAIT_L(0); PG8_MMA(1, 0, At, B0); PG8_BAR; PG8_SCHED;
            PG8_STAGE(PG8_SB(0, 1), b2 + hstep, voffB);
            PG8_WAIT_V(6); PG8_BAR; PG8_MMA(1, 1, At, B1); PG8_BAR;
            PG8_LDB(B0, 1, 0); PG8_SCHED; PG8_LDA(At, 1, 0); PG8_STAGE_A(PG8_SA(0, 1), a2, 1, last);
            PG8_WAIT_L(8); PG8_BAR; PG8_WAIT_L(0); PG8_MMA(0, 0, At, B0); PG8_BAR; PG8_SCHED;
            PG8_LDB(B1, 1, 1); PG8_STAGE(PG8_SB(1, 0), b3, voffB);
            PG8_BAR; PG8_WAIT_L(0); PG8_MMA(0, 1, At, B1); PG8_BAR;
            PG8_LDA(At, 1, 1); PG8_STAGE_A(PG8_SA(1, 0), a3, 0, last);
            PG8_BAR; PG8_WAIT_L(0); PG8_MMA(1, 0, At, B0); PG8_BAR; PG8_SCHED;
            PG8_STAGE(PG8_SB(1, 1), b3 + hstep, voffB);
            PG8_WAIT_V(6); PG8_BAR; PG8_MMA(1, 1, At, B1); PG8_BAR;
            }
        }
        if constexpr (ALIGN_EPI) { if (wr == 0) PG8_BAR; }
        if constexpr (!Epi::AFTER_DRAIN) { E(acc, cur, wr, wc, fr, fq); }
        if (!has_next) break;
#pragma unroll
        for (int a = 0; a < 2; ++a)
#pragma unroll
            for (int b = 0; b < 2; ++b)
#pragma unroll
                for (int m = 0; m < 4; ++m)
#pragma unroll
                    for (int n = 0; n < 2; ++n) acc[a][b][m][n] = (f32x4){0.f, 0.f, 0.f, 0.f};
        cur = nxt; cA = nA; cB = nB; ++ui;
        if constexpr (GATHER) {
#pragma unroll
            for (int _h = 0; _h < 2; ++_h)
#pragma unroll
                for (int _i = 0; _i < 2; ++_i) gcur[_h][_i] = gnxt[_h][_i]; }
        if constexpr (ALIGN_EPI) { if (wr == 1) PG8_BAR; }
    }
    PG8_WAIT_V(0);
    if constexpr (!ALIGN_EPI) { if (wr == 0) PG8_BAR; }
    PG8_BAR;
    if constexpr (Epi::AFTER_DRAIN) { E.fused(acc, cur, wr, wc, fr, fq, lds, wid, lane); }
#undef PG8_SA
#undef PG8_SB
#undef PG8_STAGE
#undef PG8_STAGE_A
#undef PG8_GOFF
#undef PG8_LDA
#undef PG8_LDB
#undef PG8_MMA
#undef PG8_WAIT_V
#undef PG8_WAIT_L
#undef PG8_BAR
#undef PG8_SCHED
}
}

constexpr int NWAVES = 8;
constexpr int BATCH = 2, SEQ = 8192, M = BATCH * SEQ, D = 1024;
constexpr int DIN0 = 2304, DFF0 = 2816, DFE = 3584, NEXP = 8, PLE = 256;
constexpr int ZC_B = 0, ZC_C = 512, ZC_U = 1024, ZC_Q = 1536, ZC_K = 2048, ZC_V = 2176;
constexpr int HMG_ROWS = 34816;
constexpr float EPS = 1e-6f;

constexpr size_t MiB = 1u << 20;
constexpr size_t WS_CTL = 0, CTL_ZERO_BYTES = 1 * MiB;
constexpr size_t WS_SSQA = 1 * MiB, WS_SSQB = WS_SSQA + 256 * 1024;
constexpr size_t WS_TOKE = 2 * MiB, WS_GWE = WS_TOKE + 512 * 1024, WS_RSE = WS_GWE + 512 * 1024, WS_POS = WS_RSE + 512 * 1024;
constexpr size_t WS_KM = 4 * MiB;
constexpr size_t WS_W = 16 * MiB;
constexpr size_t W_IN = WS_W, W_OUT = W_IN + (size_t)DIN0 * D * 2, W_GU0 = W_OUT + (size_t)D * D * 2, W_D0 = W_GU0 + (size_t)2 * DFF0 * D * 2,
                 W_PG0 = W_D0 + (size_t)D * DFF0 * 2, W_PP0 = W_PG0 + (size_t)D * D * 2, W_QKV = W_PP0 + (size_t)D * PLE * 2, W_O = W_QKV + (size_t)3 * D * D * 2,
                 W_PG1 = W_O + (size_t)D * D * 2, W_PP1 = W_PG1 + (size_t)D * D * 2, W_EGU = W_PP1 + (size_t)D * PLE * 2, W_ED = W_EGU + (size_t)NEXP * 2 * DFE * D * 2,
                 W_END = W_ED + (size_t)NEXP * D * DFE * 2;
constexpr size_t WS_XBA = 220 * MiB;
constexpr size_t WS_R = 252 * MiB;
static_assert(W_END <= WS_XBA, "weights overflow");
constexpr size_t R_Z = WS_R, R_MIX = WS_R + 72 * MiB, R_HM0 = WS_R, R_XBB = WS_R + 104 * MiB, R_PP = WS_R + 136 * MiB, R_PB0 = WS_R + 168 * MiB;
constexpr size_t R_Q = WS_R, R_K = WS_R + 32 * MiB, R_V = WS_R + 64 * MiB, R_PO = WS_R + 96 * MiB, R_ML = WS_R + 192 * MiB, R_LIST = WS_R + 196 * MiB, R_ATT = WS_R + 204 * MiB;
constexpr float MOBA_C2 = 0.08838834764831845f * 1.4426950408889634f;
constexpr float LOG2E = 1.4426950408889634f;
constexpr float SWA_C2 = 0.125f * 1.4426950408889634f;
constexpr size_t R_HMG = WS_R;
constexpr size_t R_Y = W_EGU;
constexpr size_t R_PB1 = WS_R, R_PP1 = WS_R + 8 * MiB;
constexpr size_t WS_END = WS_R + 238 * MiB;
static_assert((size_t)HMG_ROWS * DFE * 2 <= 238 * MiB, "HMg");
static_assert((size_t)HMG_ROWS * D * 2 <= (size_t)NEXP * 2 * DFE * D * 2, "Y overlay");
constexpr int CW_BAR = 4096;
constexpr int CW_ECNT = 16384;
constexpr int CW_LCNT = 16384 + 64;

constexpr int RING_BYTES = 131072;
constexpr int LDSCTL_OFF = RING_BYTES, MISC_OFF = LDSCTL_OFF + 320;
constexpr int LDS_BYTES = 147456;

#define GAS __attribute__((address_space(1)))
#define LAS __attribute__((address_space(3)))
typedef unsigned short bf16;
typedef unsigned v4u __attribute__((ext_vector_type(4)));
typedef unsigned v2u __attribute__((ext_vector_type(2)));
typedef float f32x4 __attribute__((ext_vector_type(4)));
typedef GAS unsigned gu32;
#define RLX_AGENT __ATOMIC_RELAXED, __HIP_MEMORY_SCOPE_AGENT
#define LDS_WAIT() asm volatile("s_waitcnt lgkmcnt(0)" ::: "memory")
#define VM_WAIT() asm volatile("s_waitcnt vmcnt(0)" ::: "memory")
__device__ __forceinline__ unsigned pk2(float lo, float hi) { return pg8::cvt_pk_bf16(lo, hi); }
__device__ __forceinline__ float bflo(unsigned w) { return __uint_as_float(w << 16); }
__device__ __forceinline__ float bfhi(unsigned w) { return __uint_as_float(w & 0xffff0000u); }

#define XB_TMO      128
#define XB_XCNT(j)  (256  + 64 * (j))
#define XB_XSUB(j)  (1280 + 64 * (j))
#define XB_XGEN(j)  (2304 + 64 * (j))
#define XB_TOP      3328
#define XB_TOPGEN   3392
#define XCD_BAR_WORDS 3456
#define XB_SPIN_CAP (1u << 18)
__device__ __forceinline__ unsigned xb_ld(unsigned* p)              { return __hip_atomic_load(p, __ATOMIC_RELAXED, __HIP_MEMORY_SCOPE_AGENT); }
__device__ __forceinline__ unsigned xb_add(unsigned* p, unsigned v) { return __hip_atomic_fetch_add(p, v, __ATOMIC_RELAXED, __HIP_MEMORY_SCOPE_AGENT); }
__device__ __forceinline__ unsigned xb_xcc_id() { return (unsigned)__builtin_amdgcn_s_getreg((3 << 11) | 20) & 0xFu; }
#define XB_SPIN(cond, bar) do { unsigned _sp = 0; while (cond) { __builtin_amdgcn_s_sleep(1); \
    if ((++_sp & 255u) == 0u) { if (xb_ld(&(bar)[XB_TMO])) break; if (_sp > XB_SPIN_CAP) { atomicAdd(&(bar)[XB_TMO], 1u); break; } } } } while (0)
struct XcdBarrier { unsigned* bar; unsigned x; volatile LAS unsigned* st; };
__device__ __forceinline__ XcdBarrier xcd_barrier_post(unsigned* bar, volatile LAS unsigned* st) {
    XcdBarrier b; b.bar = bar; b.x = xb_xcc_id(); b.st = st;
    if (threadIdx.x == 0) (void)xb_add(&bar[XB_XCNT(b.x)], 1u);
    return b;
}
__device__ __forceinline__ void xcd_barrier_complete(unsigned* bar, unsigned x, unsigned& nloc, unsigned& nx) {
    const unsigned G = gridDim.x * gridDim.y * gridDim.z;
    unsigned sum, cnt, mine, sp = 0u;
    for (;;) {
        sum = 0u; cnt = 0u; mine = 0u;
#pragma unroll
        for (unsigned j = 0; j < 16; ++j) { const unsigned c = xb_ld(&bar[XB_XCNT(j)]); sum += c; cnt += (c > 0u) ? 1u : 0u; mine = (j == x) ? c : mine; }
        if (sum == G) break;
        __builtin_amdgcn_s_sleep(1);
        if ((++sp & 255u) == 0u) { if (xb_ld(&bar[XB_TMO])) break; if (sp > XB_SPIN_CAP) { atomicAdd(&bar[XB_TMO], 1u); break; } }
    }
    nloc = mine > 0u ? mine : 1u; nx = cnt > 0u ? cnt : 1u;
}
__device__ __forceinline__ void xcd_barrier(const XcdBarrier& b) {
    asm volatile("s_waitcnt vmcnt(0)" ::: "memory");
    __syncthreads();
    if (threadIdx.x == 0) {
        unsigned* bar = b.bar;
        __builtin_amdgcn_s_waitcnt(0);
        unsigned nloc = b.st[0], nx = b.st[1];
        if (nloc == 0u) { xcd_barrier_complete(bar, b.x, nloc, nx); b.st[0] = nloc; b.st[1] = nx; }
        const unsigned old = xb_add(&bar[XB_XSUB(b.x)], 1u);
        const unsigned gen = old / nloc;
        if (old + 1u == (gen + 1u) * nloc) {
            __builtin_amdgcn_fence(__ATOMIC_RELEASE, "agent");
            asm volatile("s_waitcnt vmcnt(0)" ::: "memory");
            const unsigned og = xb_add(&bar[XB_TOP], 1u);
            const unsigned tg = og / nx;
            if (og + 1u == (tg + 1u) * nx) xb_add(&bar[XB_TOPGEN], 1u);
            else XB_SPIN(xb_ld(&bar[XB_TOPGEN]) == tg, bar);
            __builtin_amdgcn_fence(__ATOMIC_ACQUIRE, "agent");
            xb_add(&bar[XB_XGEN(b.x)], 1u);
            asm volatile("s_waitcnt vmcnt(0)" ::: "memory");
        } else {
            XB_SPIN(xb_ld(&bar[XB_XGEN(b.x)]) == gen, bar);
            __builtin_amdgcn_fence(__ATOMIC_ACQUIRE, "agent");
            asm volatile("s_waitcnt vmcnt(0)" ::: "memory");
        }
    }
    __syncthreads();
}

struct Args { const float* in[27]; float* out; unsigned char* ws; int ph_lo, ph_hi; };
struct Frame {
    LAS unsigned char* lds;
    volatile LAS unsigned* MISC;
    gu32* ctl;
    int G;
    unsigned char* ws;
    float* H;
};
__device__ __forceinline__ float wave_sum(float v) {
#pragma unroll
    for (int o = 1; o < 64; o <<= 1) v += __shfl_xor(v, o);
    return v;
}
__device__ __forceinline__ float wave_max(float v) {
#pragma unroll
    for (int o = 1; o < 64; o <<= 1) v = fmaxf(v, __shfl_xor(v, o));
    return v;
}
__device__ __forceinline__ int t5_bucket(int d) {
    if (d < 16) return d;
    int b = 16;
    b += d >= 19; b += d >= 21; b += d >= 24; b += d >= 27; b += d >= 31; b += d >= 35; b += d >= 40; b += d >= 46;
    b += d >= 52; b += d >= 59; b += d >= 67; b += d >= 77; b += d >= 87; b += d >= 99; b += d >= 113;
    return b;
}
__device__ __forceinline__ void fill_blut(LAS float* blut, const float* rel_bias, int tid) {
    for (int i = tid; i < 1024; i += NWAVES * 64) { const int h = i >> 7, d = i & 127; blut[i] = rel_bias[t5_bucket(d) * 8 + h]; }
}

__device__ __forceinline__ void p0_transpose_item(const float* W, int K, int N, const float* gain, bf16* WT, int mode, LAS float* scr, int item, int lane) {
    const int nblk = N / 32, kb = item / nblk, nb = item % nblk, k0 = 64 * kb, n0 = 32 * nb;
#pragma unroll 8
    for (int i = 0; i < 32; ++i) { const int kk = 2 * i + (lane >> 5); float w = W[(size_t)(k0 + kk) * N + n0 + (lane & 31)]; if (gain) w *= gain[k0 + kk]; scr[kk * 33 + (lane & 31)] = w; }
    LDS_WAIT(); asm volatile("" ::: "memory");
    const int c = lane & 7;
#pragma unroll
    for (int j = 0; j < 4; ++j) { const int n = (lane >> 3) + 8 * j; const LAS float* s = scr + (8 * c) * 33 + n;
        v4u o; o.x = pk2(s[0 * 33], s[1 * 33]); o.y = pk2(s[2 * 33], s[3 * 33]); o.z = pk2(s[4 * 33], s[5 * 33]); o.w = pk2(s[6 * 33], s[7 * 33]);
        const int nn = n0 + n; const int drow = mode == 0 ? nn : (256 * (nn >> 7) + (nn & 127) + (mode == 2 ? 128 : 0));
        *(GAS v4u*)(WT + (size_t)drow * K + k0 + 8 * c) = o; }
    LDS_WAIT(); asm volatile("" ::: "memory");
}
__device__ __forceinline__ float row_to_bf16_ssq(const float* xrow, bf16* orow, int lane) {
    const GAS f32x4* xr = (const GAS f32x4*)xrow + lane;
    f32x4 v[4]; float s = 0.f;
#pragma unroll
    for (int j = 0; j < 4; ++j) { v[j] = xr[64 * j]; s += (v[j].x * v[j].x + v[j].y * v[j].y) + (v[j].z * v[j].z + v[j].w * v[j].w); }
    GAS v2u* o8 = (GAS v2u*)orow + lane;
#pragma unroll
    for (int j = 0; j < 4; ++j) { v2u w; w.x = pk2(v[j].x, v[j].y); w.y = pk2(v[j].z, v[j].w); o8[64 * j] = w; }
    return wave_sum(s);
}
__device__ __forceinline__ void cvt_f32_bf16_flat(const float* src, bf16* dst, size_t n8, int gt, int ngt) {
    for (size_t i = gt; i < n8; i += ngt) { const f32x4 a = ((const GAS f32x4*)src)[2 * i], b = ((const GAS f32x4*)src)[2 * i + 1];
        v4u o; o.x = pk2(a.x, a.y); o.y = pk2(a.z, a.w); o.z = pk2(b.x, b.y); o.w = pk2(b.z, b.w); ((GAS v4u*)dst)[i] = o; }
}
__device__ __forceinline__ void p0_prologue(Frame& F, const Args& a) {
    int tid_ = threadIdx.x; asm volatile("" : "+v"(tid_)); const int tid = tid_, lane = tid & 63, wave = __builtin_amdgcn_readfirstlane(tid >> 6); (void)lane; (void)wave;
    LAS float* scr = (LAS float*)(F.lds + wave * 16384);
    const int gw = blockIdx.x * NWAVES + wave, NGW = F.G * NWAVES;
    unsigned char* ws = F.ws;
    constexpr int I_WIN = 16 * 72, I_SQ = 16 * 32, I_F0 = 16 * 88, I_D0 = 44 * 32, I_PP = 4 * 32, I_QKV = 16 * 96, I_EG = 16 * 112, I_ED = 56 * 32;
    constexpr int NITEMS = I_WIN + I_SQ + 2 * I_F0 + I_D0 + I_SQ + I_PP + I_QKV + I_SQ + I_SQ + I_PP + 8 * (2 * I_EG + I_ED);
    for (int it = gw; it < NITEMS; it += NGW) {
        int r = it;
        if (r < I_WIN) { p0_transpose_item(a.in[5], D, DIN0, a.in[4], (bf16*)(ws + W_IN), 0, scr, r, lane); continue; } r -= I_WIN;
        if (r < I_SQ) { p0_transpose_item(a.in[8], D, D, nullptr, (bf16*)(ws + W_OUT), 0, scr, r, lane); continue; } r -= I_SQ;
        if (r < I_F0) { p0_transpose_item(a.in[10], D, DFF0, a.in[9], (bf16*)(ws + W_GU0), 1, scr, r, lane); continue; } r -= I_F0;
        if (r < I_F0) { p0_transpose_item(a.in[11], D, DFF0, a.in[9], (bf16*)(ws + W_GU0), 2, scr, r, lane); continue; } r -= I_F0;
        if (r < I_D0) { p0_transpose_item(a.in[12], DFF0, D, nullptr, (bf16*)(ws + W_D0), 0, scr, r, lane); continue; } r -= I_D0;
        if (r < I_SQ) { p0_transpose_item(a.in[14], D, D, a.in[13], (bf16*)(ws + W_PG0), 0, scr, r, lane); continue; } r -= I_SQ;
        if (r < I_PP) { p0_transpose_item(a.in[15], PLE, D, nullptr, (bf16*)(ws + W_PP0), 0, scr, r, lane); continue; } r -= I_PP;
        if (r < I_QKV) { p0_transpose_item(a.in[17], D, 3 * D, a.in[16], (bf16*)(ws + W_QKV), 0, scr, r, lane); continue; } r -= I_QKV;
        if (r < I_SQ) { p0_transpose_item(a.in[18], D, D, nullptr, (bf16*)(ws + W_O), 0, scr, r, lane); continue; } r -= I_SQ;
        if (r < I_SQ) { p0_transpose_item(a.in[25], D, D, a.in[24], (bf16*)(ws + W_PG1), 0, scr, r, lane); continue; } r -= I_SQ;
        if (r < I_PP) { p0_transpose_item(a.in[26], PLE, D, nullptr, (bf16*)(ws + W_PP1), 0, scr, r, lane); continue; } r -= I_PP;
        const int e = r / (2 * I_EG + I_ED); r -= e * (2 * I_EG + I_ED);
        if (r < I_EG) { p0_transpose_item(a.in[21] + (size_t)e * D * DFE, D, DFE, a.in[19], (bf16*)(ws + W_EGU) + (size_t)e * 2 * DFE * D, 1, scr, r, lane); continue; } r -= I_EG;
        if (r < I_EG) { p0_transpose_item(a.in[22] + (size_t)e * D * DFE, D, DFE, a.in[19], (bf16*)(ws + W_EGU) + (size_t)e * 2 * DFE * D, 2, scr, r, lane); continue; } r -= I_EG;
        p0_transpose_item(a.in[23] + (size_t)e * DFE * D, DFE, D, nullptr, (bf16*)(ws + W_ED) + (size_t)e * D * DFE, 0, scr, r, lane);
    }
    for (int m = gw; m < M; m += NGW) { const float s = row_to_bf16_ssq(a.in[0] + (size_t)m * D, (bf16*)(ws + WS_XBA) + (size_t)m * D, lane);
        if (lane == 0) *(GAS f32x4*)((float*)(ws + WS_SSQA) + 4 * (size_t)m) = (f32x4){s, 0.f, 0.f, 0.f}; }
    cvt_f32_bf16_flat(a.in[1], (bf16*)(ws + R_PB0), (size_t)M * PLE / 8, blockIdx.x * (NWAVES * 64) + tid, F.G * NWAVES * 64);
}

typedef short bf16x8_t __attribute__((ext_vector_type(8)));
typedef short s16x4_t __attribute__((ext_vector_type(4)));
typedef float f32x16 __attribute__((ext_vector_type(16)));
constexpr int KSTR = 272, VSTR = 320;
constexpr int KT_BYTES = 64 * KSTR, VT_BYTES = 64 * VSTR, KV_STAGE = KT_BYTES + VT_BYTES;
constexpr int ATT_LDS_KV = 8192;
constexpr int KSTR64 = 144, VSTR64 = 192;
__device__ __forceinline__ int crow16(int i, int h) { return (i & 3) + 8 * (i >> 2) + 4 * h; }
__device__ __forceinline__ int list_off(int j) { return 256 * (31 * j - (j * (j - 1)) / 2); }
__device__ __forceinline__ f32x16 mfma32(bf16x8_t a, bf16x8_t b, f32x16 c) { return __builtin_amdgcn_mfma_f32_32x32x16_bf16(a, b, c, 0, 0, 0); }
__device__ __forceinline__ s16x4_t vtr(const LAS unsigned char* p) { return __builtin_bit_cast(s16x4_t, __builtin_amdgcn_ds_read_tr16_b64_v4i16((LAS s16x4_t*)p)); }
struct KVRegs { v4u k0, k1, v0, v1; };
__device__ __forceinline__ void kv_load(KVRegs& r, const bf16* Kb, const bf16* Vb, size_t row0, int h, int tid) {
    const size_t off = (row0 + (tid >> 3)) * D + h * 128 + (tid & 7) * 8;
    r.k0 = *(const GAS v4u*)(Kb + off); r.k1 = *(const GAS v4u*)(Kb + off + 64); r.v0 = *(const GAS v4u*)(Vb + off); r.v1 = *(const GAS v4u*)(Vb + off + 64);
}
__device__ __forceinline__ void kv_store(const KVRegs& r, LAS unsigned char* stage, int tid) {
    LAS unsigned char* kp = stage + (tid >> 3) * KSTR + (tid & 7) * 16; LAS unsigned char* vp = stage + KT_BYTES + (tid >> 3) * VSTR + (tid & 7) * 16;
    *(LAS v4u*)kp = r.k0; *(LAS v4u*)(kp + 128) = r.k1; *(LAS v4u*)vp = r.v0; *(LAS v4u*)(vp + 128) = r.v1;
}
template <int NKS, int KS_> __device__ __forceinline__ void attn_qk(const LAS unsigned char* Kt, const bf16x8_t (&qf)[NKS], f32x16& p0, f32x16& p1, int lane) {
    const LAS unsigned char* kb = Kt + (lane & 31) * KS_ + (lane >> 5) * 16;
#pragma unroll
    for (int ks = 0; ks < NKS; ++ks) { const bf16x8_t a0 = *(const LAS bf16x8_t*)(kb + ks * 32), a1 = *(const LAS bf16x8_t*)(kb + 32 * KS_ + ks * 32);
        if (ks == 0) { f32x16 z; for (int i = 0; i < 16; ++i) z[i] = 0.f; p0 = mfma32(a0, qf[0], z); p1 = mfma32(a1, qf[0], z); }
        else { p0 = mfma32(a0, qf[ks], p0); p1 = mfma32(a1, qf[ks], p1); } }
}
template <int NDT, int VS_> __device__ __forceinline__ void attn_softmax_pv(const LAS unsigned char* Vt, f32x16& p0, f32x16& p1, f32x16 (&o)[NDT], float& m, float& l, int lane) {
    float mt = p0[0];
#pragma unroll
    for (int i = 1; i < 16; ++i) mt = fmaxf(mt, p0[i]);
#pragma unroll
    for (int i = 0; i < 16; ++i) mt = fmaxf(mt, p1[i]);
    mt = fmaxf(mt, __shfl_xor(mt, 32));
    const float mn = fmaxf(m, mt); const float ms = mn == -INFINITY ? 0.f : mn;
    const float alpha = __builtin_amdgcn_exp2f(m - ms);
    float ls = 0.f;
#pragma unroll
    for (int i = 0; i < 16; ++i) { p0[i] = __builtin_amdgcn_exp2f(p0[i] - ms); ls += p0[i]; }
#pragma unroll
    for (int i = 0; i < 16; ++i) { p1[i] = __builtin_amdgcn_exp2f(p1[i] - ms); ls += p1[i]; }
    l = l * alpha + ls; m = mn;
#pragma unroll
    for (int dt = 0; dt < NDT; ++dt)
#pragma unroll
        for (int i = 0; i < 16; ++i) o[dt][i] *= alpha;
    bf16x8_t pb[4];
#pragma unroll
    for (int s = 0; s < 4; ++s) { v4u w;
        if (s < 2) { w.x = pk2(p0[8 * s + 0], p0[8 * s + 1]); w.y = pk2(p0[8 * s + 2], p0[8 * s + 3]); w.z = pk2(p0[8 * s + 4], p0[8 * s + 5]); w.w = pk2(p0[8 * s + 6], p0[8 * s + 7]); }
        else { const int t = s - 2; w.x = pk2(p1[8 * t + 0], p1[8 * t + 1]); w.y = pk2(p1[8 * t + 2], p1[8 * t + 3]); w.z = pk2(p1[8 * t + 4], p1[8 * t + 5]); w.w = pk2(p1[8 * t + 6], p1[8 * t + 7]); }
        pb[s] = __builtin_bit_cast(bf16x8_t, w); }
    const int i16 = lane & 15, q4 = i16 >> 2, p4 = i16 & 3, blk = (lane >> 4) & 1, hh = lane >> 5;
    const LAS unsigned char* vb = Vt + (4 * hh + q4) * VS_ + blk * 32 + p4 * 8;
#pragma unroll
    for (int dt = 0; dt < NDT; ++dt)
#pragma unroll
        for (int s = 0; s < 4; ++s) { const s16x4_t lo = vtr(vb + (16 * s) * VS_ + dt * 64), hi = vtr(vb + (16 * s + 8) * VS_ + dt * 64);
            const bf16x8_t vf = __builtin_shufflevector(lo, hi, 0, 1, 2, 3, 4, 5, 6, 7);
            o[dt] = mfma32(vf, pb[s], o[dt]); }
}

__device__ __forceinline__ void l0_mixer_naive(Frame& F, const Args& a) {
    int tid_ = threadIdx.x; asm volatile("" : "+v"(tid_)); const int tid = tid_, lane = tid & 63, wave = __builtin_amdgcn_readfirstlane(tid >> 6); (void)lane; (void)wave;
    const bf16* Z = (const bf16*)(F.ws + R_Z); bf16* MIX = (bf16*)(F.ws + R_MIX);
    const int gw = blockIdx.x * NWAVES + wave, NGW = F.G * NWAVES;
    {
        const float* cw = a.in[6];
        const int c0 = lane * 8;
        float w0[8], w1[8], w2[8];
#pragma unroll
        for (int j = 0; j < 8; ++j) { w0[j] = cw[c0 + j]; w1[j] = cw[512 + c0 + j]; w2[j] = cw[1024 + c0 + j]; }
        for (int tok = gw; tok < M; tok += NGW) {
            const int t = tok & (SEQ - 1);
            float acc[8];
#pragma unroll
            for (int j = 0; j < 8; ++j) acc[j] = 0.f;
#pragma unroll
            for (int dt = 0; dt < 3; ++dt) {
                if (t - dt >= 0) {
                    const bf16* zr = Z + (size_t)(tok - dt) * DIN0;
                    const v4u cc = *(const GAS v4u*)(zr + ZC_C + c0), uu = *(const GAS v4u*)(zr + ZC_U + c0);
                    const unsigned cw4[4] = {cc.x, cc.y, cc.z, cc.w}, uw4[4] = {uu.x, uu.y, uu.z, uu.w};
#pragma unroll
                    for (int q = 0; q < 4; ++q) { const float p0 = bflo(cw4[q]) * bflo(uw4[q]), p1 = bfhi(cw4[q]) * bfhi(uw4[q]);
                        const float wa = dt == 0 ? w2[2 * q] : (dt == 1 ? w1[2 * q] : w0[2 * q]), wb = dt == 0 ? w2[2 * q + 1] : (dt == 1 ? w1[2 * q + 1] : w0[2 * q + 1]);
                        acc[2 * q] += wa * p0; acc[2 * q + 1] += wb * p1; }
                }
            }
            const v4u bb = *(const GAS v4u*)(Z + (size_t)tok * DIN0 + ZC_B + c0);
            v4u o; o.x = pk2(bflo(bb.x) * acc[0], bfhi(bb.x) * acc[1]); o.y = pk2(bflo(bb.y) * acc[2], bfhi(bb.y) * acc[3]);
            o.z = pk2(bflo(bb.z) * acc[4], bfhi(bb.z) * acc[5]); o.w = pk2(bflo(bb.w) * acc[6], bfhi(bb.w) * acc[7]);
            *(GAS v4u*)(MIX + (size_t)tok * D + c0) = o;
        }
    }
    LAS float* blut = (LAS float*)F.lds;
    __syncthreads();
    for (int i = tid; i < 1024; i += NWAVES * 64) { const int hd = i >> 7, d = i & 127; blut[i] = a.in[2][t5_bucket(d) * 8 + hd] * LOG2E; }
    LAS unsigned char* Kl = F.lds + 4096; LAS unsigned char* Vl = Kl + 256 * KSTR64;
    const int r32 = lane & 31, hh = lane >> 5;
    for (int u = blockIdx.x; u < 2 * 2 * 64; u += F.G) {
        const int qb = u & 63, kvh = (u >> 6) & 1, b = u >> 7;
        __syncthreads();
#pragma unroll
        for (int i = 0; i < 4; ++i) { const int c = tid + 512 * i, row = c >> 3, c16 = c & 7; int pos = 128 * (qb - 1) + row; pos = pos < 0 ? 0 : pos;
            const bf16* zr = Z + (size_t)(b * SEQ + pos) * DIN0 + kvh * 64 + c16 * 8;
            *(LAS v4u*)(Kl + row * KSTR64 + c16 * 16) = *(const GAS v4u*)(zr + ZC_K); *(LAS v4u*)(Vl + row * VSTR64 + c16 * 16) = *(const GAS v4u*)(zr + ZC_V); }
        __syncthreads();
        const int g = wave >> 1, qh = wave & 1, hd = kvh * 4 + g;
        const float sinkl = a.in[7][hd] * LOG2E;
#pragma unroll 1
        for (int sub = 0; sub < 2; ++sub) {
            const int qrel = 64 * qh + 32 * sub + r32;
            const int tok = b * SEQ + 128 * qb + qrel;
            bf16x8_t qf[4];
            { const GAS bf16x8_t* qp = (const GAS bf16x8_t*)(Z + (size_t)tok * DIN0 + ZC_Q + hd * 64 + 8 * hh);
#pragma unroll
              for (int ks = 0; ks < 4; ++ks) qf[ks] = qp[2 * ks]; }
            f32x16 o[2];
#pragma unroll
            for (int dt = 0; dt < 2; ++dt)
#pragma unroll
                for (int i = 0; i < 16; ++i) o[dt][i] = 0.f;
            float m = -INFINITY, l = 0.f;
#pragma unroll 1
            for (int kk = 0; kk < 3; ++kk) {
                const int kt = qh + kk;
                if (qb == 0 && kt < 2) continue;
                f32x16 p0, p1;
                attn_qk<4, KSTR64>(Kl + kt * 64 * KSTR64, qf, p0, p1, lane);
#pragma unroll
                for (int i = 0; i < 16; ++i) { const int d0 = (128 + qrel) - (kt * 64 + crow16(i, hh)), d1 = d0 - 32;
                    p0[i] = (d0 >= 0 && d0 < 128) ? p0[i] + blut[hd * 128 + d0] : -INFINITY;
                    p1[i] = (d1 >= 0 && d1 < 128) ? p1[i] + blut[hd * 128 + d1] : -INFINITY; }
                attn_softmax_pv<2, VSTR64>(Vl + kt * 64 * VSTR64, p0, p1, o, m, l, lane);
            }
            l += __shfl_xor(l, 32);
            const float inv = 1.0f / (l + __builtin_amdgcn_exp2f(sinkl - m));
            bf16* mo = MIX + (size_t)tok * D + 512 + hd * 64 + 4 * hh;
#pragma unroll
            for (int dt = 0; dt < 2; ++dt)
#pragma unroll
                for (int gg = 0; gg < 4; ++gg) { v2u w; w.x = pk2(o[dt][4 * gg] * inv, o[dt][4 * gg + 1] * inv); w.y = pk2(o[dt][4 * gg + 2] * inv, o[dt][4 * gg + 3] * inv); *(GAS v2u*)(mo + 32 * dt + 8 * gg) = w; }
        }
    }
}

__device__ __forceinline__ void l1_kmean(Frame& F) {
    int tid_ = threadIdx.x; asm volatile("" : "+v"(tid_)); const int tid = tid_, lane = tid & 63, wave = __builtin_amdgcn_readfirstlane(tid >> 6); (void)lane; (void)wave;
    const bf16* Kb = (const bf16*)(F.ws + R_K); float* KM = (float*)(F.ws + WS_KM);
    LAS float* red = (LAS float*)F.lds;
    for (int task = blockIdx.x; task < 2 * 32 * 8; task += F.G) {
        const int h = task & 7, bn = task >> 3;
        const bf16* base = Kb + (size_t)(bn * 256 + wave * 32) * D + h * 128 + 2 * lane;
        float s0 = 0.f, s1 = 0.f;
        for (int r = 0; r < 32; ++r) { const unsigned w = *(const GAS unsigned*)(base + (size_t)r * D); s0 += bflo(w); s1 += bfhi(w); }
        red[wave * 128 + 2 * lane] = s0; red[wave * 128 + 2 * lane + 1] = s1;
        __syncthreads();
        if (tid < 128) { float s = 0.f;
#pragma unroll
            for (int w = 0; w < 8; ++w) s += red[w * 128 + tid];
            KM[(size_t)bn * D + h * 128 + tid] = s * (1.0f / 256.0f); }
        __syncthreads();
    }
}
__device__ __forceinline__ void l1_moba_select(Frame& F) {
    int tid_ = threadIdx.x; asm volatile("" : "+v"(tid_)); const int tid = tid_, lane = tid & 63, wave = __builtin_amdgcn_readfirstlane(tid >> 6); (void)lane; (void)wave;
    const bf16* Qb = (const bf16*)(F.ws + R_Q); const float* KM = (const float*)(F.ws + WS_KM);
    unsigned* lcnt = (unsigned*)(F.ctl + CW_LCNT); int* lists = (int*)(F.ws + R_LIST);
    LAS float* kmL = (LAS float*)F.lds;
    for (int chunk = blockIdx.x; chunk < 256; chunk += F.G) {
        const int bh = chunk >> 4, g = chunk & 15, b = bh >> 3, h = bh & 7;
        __syncthreads();
        for (int i = tid; i < 4096; i += NWAVES * 64) kmL[i] = KM[(size_t)(b * 32 + (i >> 7)) * D + h * 128 + (i & 127)];
        __syncthreads();
        const int t = g * 512 + wave * 64 + lane, qblk = (g * 512 + wave * 64) >> 8;
        if (qblk == 0) continue;
        float acc[31];
#pragma unroll
        for (int n = 0; n < 31; ++n) acc[n] = 0.f;
        const GAS v4u* qr = (const GAS v4u*)(Qb + (size_t)(b * SEQ + t) * D + h * 128);
#pragma unroll 1
        for (int c = 0; c < 16; ++c) { const v4u w = qr[c];
            const float q0 = bflo(w.x), q1 = bfhi(w.x), q2 = bflo(w.y), q3 = bfhi(w.y), q4 = bflo(w.z), q5 = bfhi(w.z), q6 = bflo(w.w), q7 = bfhi(w.w);
#pragma unroll
            for (int n = 0; n < 31; ++n) if (n < qblk) { const f32x4 ka = *(const LAS f32x4*)(kmL + n * 128 + c * 8), kb = *(const LAS f32x4*)(kmL + n * 128 + c * 8 + 4);
                acc[n] += (q0 * ka.x + q1 * ka.y) + (q2 * ka.z + q3 * ka.w) + (q4 * kb.x + q5 * kb.y) + (q6 * kb.z + q7 * kb.w); } }
        float v1 = -INFINITY, v2 = -INFINITY, v3 = -INFINITY; int i1 = -1, i2 = -1, i3 = -1;
#pragma unroll
        for (int n = 0; n < 31; ++n) if (n < qblk) { const float v = acc[n];
            if (v > v1) { v3 = v2; i3 = i2; v2 = v1; i2 = i1; v1 = v; i1 = n; } else if (v > v2) { v3 = v2; i3 = i2; v2 = v; i2 = n; } else if (v > v3) { v3 = v; i3 = n; } }
        for (int j = 0; j < qblk; ++j) {
            const bool hit = (i1 == j) | (i2 == j) | (i3 == j);
            const unsigned long long mk = __ballot(hit);
            if (mk == 0ull) continue;
            const int cntj = __popcll(mk);
            unsigned base = 0;
            if (lane == 0) base = __hip_atomic_fetch_add(lcnt + bh * 32 + j, (unsigned)cntj, __ATOMIC_RELAXED, __HIP_MEMORY_SCOPE_AGENT);
            base = __builtin_amdgcn_readfirstlane(base);
            if (hit) { const int off = __popcll(mk & ((1ull << lane) - 1ull)); const int rk = (i1 == j) ? 0 : ((i2 == j) ? 1 : 2);
                const unsigned idx = base + off;
                if (idx < (unsigned)(256 * (31 - j))) lists[(size_t)bh * 126976 + list_off(j) + idx] = t | (rk << 13); }
        }
    }
}
__device__ __forceinline__ void l1_moba_partial(Frame& F, const Args& a) {
    int tid_ = threadIdx.x; asm volatile("" : "+v"(tid_)); const int tid = tid_, lane = tid & 63, wave = __builtin_amdgcn_readfirstlane(tid >> 6); (void)lane; (void)wave;
    const bf16* Qb = (const bf16*)(F.ws + R_Q); const bf16* Kb = (const bf16*)(F.ws + R_K); const bf16* Vb = (const bf16*)(F.ws + R_V);
    bf16* PO = (bf16*)(F.ws + R_PO); float* ML = (float*)(F.ws + R_ML);
    const unsigned* lcnt = (const unsigned*)(F.ctl + CW_LCNT); const int* lists = (const int*)(F.ws + R_LIST);
    const int r32 = lane & 31, hh = lane >> 5;
    LAS float* blut = (LAS float*)F.lds; LAS int* pre = (LAS int*)(F.lds + 4096);
    for (int i = tid; i < 1024; i += NWAVES * 64) { const int hd = i >> 7, d = i & 127; blut[i] = (a.in[2][t5_bucket(d) * 8 + hd] - a.in[2][31 * 8 + hd]) * LOG2E; }
    {
        const int li = tid; const int jj = li & 31; unsigned c = lcnt[li]; const unsigned cap = 256u * (31 - jj); c = c > cap ? cap : c;
        const int tiles = (int)((c + 255u) >> 8);
        int x = tiles;
#pragma unroll
        for (int o = 1; o < 64; o <<= 1) { const int y = __shfl_up(x, o); if (lane >= o) x += y; }
        LAS int* wt = pre + 520;
        if (lane == 63) wt[wave] = x;
        __syncthreads();
        int wo = 0;
#pragma unroll
        for (int w = 0; w < 8; ++w) if (w < wave) wo += wt[w];
        pre[li + 1] = wo + x; if (li == 0) pre[0] = 0;
        __syncthreads();
    }
    const int total = pre[512];
    LAS unsigned char* kv = F.lds + ATT_LDS_KV;
    for (int u = blockIdx.x; u < total; u += F.G) {
        int lo = 0, hi = 511;
        while (lo < hi) { const int mid = (lo + hi + 1) >> 1; if (pre[mid] <= u) lo = mid; else hi = mid - 1; }
        const int li = lo, tile = u - pre[li], bh = li >> 5, j = li & 31, b = bh >> 3, h = bh & 7;
        unsigned nl = lcnt[li]; { const unsigned cap = 256u * (31 - j); nl = nl > cap ? cap : nl; }
        const int ridx = tile * 256 + wave * 32 + r32; const bool rvalid = ridx < (int)nl;
        const int ent = lists[(size_t)bh * 126976 + list_off(j) + (rvalid ? ridx : 0)];
        const int t = ent & 8191, rk = ent >> 13;
        bf16x8_t qf[8];
        { const GAS bf16x8_t* qp = (const GAS bf16x8_t*)(Qb + (size_t)(b * SEQ + t) * D + h * 128 + 8 * hh);
#pragma unroll
          for (int ks = 0; ks < 8; ++ks) qf[ks] = qp[2 * ks]; }
        const bool near = t < j * 256 + 382;
        const bool anynear = __any(near);
        f32x16 o[4];
#pragma unroll
        for (int dt = 0; dt < 4; ++dt)
#pragma unroll
            for (int i = 0; i < 16; ++i) o[dt][i] = 0.f;
        float m = -INFINITY, l = 0.f;
        const size_t krow0 = (size_t)b * SEQ + j * 256;
        KVRegs kr;
        __syncthreads();
        kv_load(kr, Kb, Vb, krow0, h, tid); kv_store(kr, kv, tid);
        __syncthreads();
#pragma unroll 1
        for (int kt = 0; kt < 4; ++kt) {
            if (kt < 3) kv_load(kr, Kb, Vb, krow0 + (kt + 1) * 64, h, tid);
            const LAS unsigned char* st = kv + (kt & 1) * KV_STAGE;
            f32x16 p0, p1;
            attn_qk<8, KSTR>(st, qf, p0, p1, lane);
            if (anynear && kt >= 2) { const int kp0 = j * 256 + kt * 64;
#pragma unroll
                for (int i = 0; i < 16; ++i) { int d0 = t - (kp0 + crow16(i, hh)); int d1 = d0 - 32; d0 = d0 > 127 ? 127 : d0; d1 = d1 > 127 ? 127 : d1;
                    p0[i] += blut[h * 128 + d0]; p1[i] += blut[h * 128 + d1]; } }
            attn_softmax_pv<4, VSTR>(st + KT_BYTES, p0, p1, o, m, l, lane);
            if (kt < 3) kv_store(kr, kv + ((kt + 1) & 1) * KV_STAGE, tid);
            __syncthreads();
        }
        l += __shfl_xor(l, 32);
        if (rvalid) {
            const size_t pidx = ((size_t)((rk * 2 + b) * 8 + h) * SEQ + t);
            if (hh == 0) *(GAS pg8::f32x2*)(ML + pidx * 2) = (pg8::f32x2){m, l};
            bf16* po = PO + pidx * 128 + 4 * hh;
#pragma unroll
            for (int dt = 0; dt < 4; ++dt)
#pragma unroll
                for (int g = 0; g < 4; ++g) { v2u w; w.x = pk2(o[dt][4 * g], o[dt][4 * g + 1]); w.y = pk2(o[dt][4 * g + 2], o[dt][4 * g + 3]); *(GAS v2u*)(po + 32 * dt + 8 * g) = w; }
        }
    }
}
__device__ __forceinline__ void l1_moba_own_merge(Frame& F, const Args& a) {
    int tid_ = threadIdx.x; asm volatile("" : "+v"(tid_)); const int tid = tid_, lane = tid & 63, wave = __builtin_amdgcn_readfirstlane(tid >> 6); (void)lane; (void)wave;
    const bf16* Qb = (const bf16*)(F.ws + R_Q); const bf16* Kb = (const bf16*)(F.ws + R_K); const bf16* Vb = (const bf16*)(F.ws + R_V);
    const bf16* PO = (const bf16*)(F.ws + R_PO); const float* ML = (const float*)(F.ws + R_ML); bf16* ATT = (bf16*)(F.ws + R_ATT);
    const int r32 = lane & 31, hh = lane >> 5;
    LAS float* blut = (LAS float*)F.lds;
    __syncthreads();
    for (int i = tid; i < 1024; i += NWAVES * 64) { const int hd = i >> 7, d = i & 127; blut[i] = a.in[2][t5_bucket(d) * 8 + hd] * LOG2E; }
    __syncthreads();
    LAS unsigned char* kv = F.lds + ATT_LDS_KV;
    for (int u = blockIdx.x; u < 512; u += F.G) {
        const int bh = u >> 5, ib = u & 31, b = bh >> 3, h = bh & 7;
        const int qrel = wave * 32 + r32, t = ib * 256 + qrel;
        bf16x8_t qf[8];
        { const GAS bf16x8_t* qp = (const GAS bf16x8_t*)(Qb + (size_t)(b * SEQ + t) * D + h * 128 + 8 * hh);
#pragma unroll
          for (int ks = 0; ks < 8; ++ks) qf[ks] = qp[2 * ks]; }
        f32x16 o[4];
#pragma unroll
        for (int dt = 0; dt < 4; ++dt)
#pragma unroll
            for (int i = 0; i < 16; ++i) o[dt][i] = 0.f;
        float m = -INFINITY, l = 0.f;
        const size_t krow0 = (size_t)b * SEQ + ib * 256;
        KVRegs kr;
        __syncthreads();
        kv_load(kr, Kb, Vb, krow0, h, tid); kv_store(kr, kv, tid);
        __syncthreads();
#pragma unroll 1
        for (int kt = 0; kt < 4; ++kt) {
            if (kt < 3) kv_load(kr, Kb, Vb, krow0 + (kt + 1) * 64, h, tid);
            const LAS unsigned char* st = kv + (kt & 1) * KV_STAGE;
            if (kt * 64 <= wave * 32 + 31) {
                f32x16 p0, p1;
                attn_qk<8, KSTR>(st, qf, p0, p1, lane);
#pragma unroll
                for (int i = 0; i < 16; ++i) { const int d0 = qrel - (kt * 64 + crow16(i, hh)), d1 = d0 - 32;
                    p0[i] = d0 >= 0 ? p0[i] + blut[h * 128 + (d0 > 127 ? 127 : d0)] : -INFINITY;
                    p1[i] = d1 >= 0 ? p1[i] + blut[h * 128 + (d1 > 127 ? 127 : d1)] : -INFINITY; }
                attn_softmax_pv<4, VSTR>(st + KT_BYTES, p0, p1, o, m, l, lane);
            }
            if (kt < 3) kv_store(kr, kv + ((kt + 1) & 1) * KV_STAGE, tid);
            __syncthreads();
        }
        l += __shfl_xor(l, 32);
        const int nsel = ib < 3 ? ib : 3;
        const float c31 = blut[h * 128 + 127];
        float mr[3], lr[3]; float mx = m;
#pragma unroll
        for (int r = 0; r < 3; ++r) { mr[r] = -INFINITY; lr[r] = 0.f;
            if (r < nsel) { const size_t pidx = ((size_t)((r * 2 + b) * 8 + h) * SEQ + t); const pg8::f32x2 v = *(const GAS pg8::f32x2*)(ML + pidx * 2); mr[r] = v[0] + c31; lr[r] = v[1]; mx = fmaxf(mx, mr[r]); } }
        const float f0 = __builtin_amdgcn_exp2f(m - mx);
        float lt = l * f0;
#pragma unroll
        for (int dt = 0; dt < 4; ++dt)
#pragma unroll
            for (int i = 0; i < 16; ++i) o[dt][i] *= f0;
#pragma unroll
        for (int r = 0; r < 3; ++r) if (r < nsel) { const float fr = __builtin_amdgcn_exp2f(mr[r] - mx); lt += lr[r] * fr;
            const bf16* po = PO + ((size_t)((r * 2 + b) * 8 + h) * SEQ + t) * 128 + 4 * hh;
#pragma unroll
            for (int dt = 0; dt < 4; ++dt)
#pragma unroll
                for (int g = 0; g < 4; ++g) { const v2u w = *(const GAS v2u*)(po + 32 * dt + 8 * g);
                    o[dt][4 * g] += fr * bflo(w.x); o[dt][4 * g + 1] += fr * bfhi(w.x); o[dt][4 * g + 2] += fr * bflo(w.y); o[dt][4 * g + 3] += fr * bfhi(w.y); } }
        const float inv = 1.0f / lt;
        bf16* ao = ATT + (size_t)(b * SEQ + t) * D + h * 128 + 4 * hh;
#pragma unroll
        for (int dt = 0; dt < 4; ++dt)
#pragma unroll
            for (int g = 0; g < 4; ++g) { v2u w; w.x = pk2(o[dt][4 * g] * inv, o[dt][4 * g + 1] * inv); w.y = pk2(o[dt][4 * g + 2] * inv, o[dt][4 * g + 3] * inv); *(GAS v2u*)(ao + 32 * dt + 8 * g) = w; }
    }
}

__device__ __forceinline__ void l1_route(Frame& F, const Args& a) {
    int tid_ = threadIdx.x; asm volatile("" : "+v"(tid_)); const int tid = tid_, lane = tid & 63, wave = __builtin_amdgcn_readfirstlane(tid >> 6); (void)lane; (void)wave;
    LAS float* WrL = (LAS float*)F.lds;
    LAS int* lcnt = (LAS int*)(F.lds + 32768);
    LAS int* lbase = lcnt + 8;
    LAS int* tiE = lcnt + 16;
    LAS int* tiL = tiE + 128;
    LAS float* tiW = (LAS float*)(tiL + 128);
    LAS float* tiR = tiW + 128;
    const float* router = a.in[20]; const float* gain = a.in[19];
    for (int i = tid; i < 8192; i += NWAVES * 64) WrL[i] = router[i] * gain[i >> 3];
    unsigned* gcnt = (unsigned*)(F.ctl + CW_ECNT);
    int* tok_e = (int*)(F.ws + WS_TOKE); float* gw_e = (float*)(F.ws + WS_GWE); float* rs_e = (float*)(F.ws + WS_RSE); int* pos = (int*)(F.ws + WS_POS);
    for (int chunk = blockIdx.x; chunk < M / 64; chunk += F.G) {
        if (tid < 8) lcnt[tid] = 0;
        __syncthreads();
        for (int tt = wave; tt < 64; tt += NWAVES) {
            const int tok = chunk * 64 + tt;
            const GAS f32x4* hr = (const GAS f32x4*)(F.H + (size_t)tok * D) + lane;
            float lg[8]; float ss = 0.f;
#pragma unroll
            for (int e = 0; e < 8; ++e) lg[e] = 0.f;
#pragma unroll
            for (int j = 0; j < 4; ++j) { const f32x4 hv = hr[64 * j]; const float hx[4] = {hv.x, hv.y, hv.z, hv.w};
#pragma unroll
                for (int q = 0; q < 4; ++q) { const int k = j * 256 + lane * 4 + q; const f32x4 wa = *(const LAS f32x4*)(WrL + k * 8), wb = *(const LAS f32x4*)(WrL + k * 8 + 4);
                    ss += hx[q] * hx[q];
                    lg[0] += hx[q] * wa.x; lg[1] += hx[q] * wa.y; lg[2] += hx[q] * wa.z; lg[3] += hx[q] * wa.w; lg[4] += hx[q] * wb.x; lg[5] += hx[q] * wb.y; lg[6] += hx[q] * wb.z; lg[7] += hx[q] * wb.w; } }
            ss = wave_sum(ss);
#pragma unroll
            for (int e = 0; e < 8; ++e) lg[e] = wave_sum(lg[e]);
            const float rs = rsqrtf(ss * (1.0f / 1024.0f) + EPS);
            float v0 = lg[0]; int e0 = 0;
#pragma unroll
            for (int e = 1; e < 8; ++e) if (lg[e] > v0) { v0 = lg[e]; e0 = e; }
            float v1 = -INFINITY; int e1 = 0;
#pragma unroll
            for (int e = 0; e < 8; ++e) if (e != e0 && lg[e] > v1) { v1 = lg[e]; e1 = e; }
            const float w0 = 1.0f / (1.0f + __expf((v1 - v0) * rs)), w1 = 1.0f - w0;
            if (lane == 0) { const int l0 = __hip_atomic_fetch_add(&lcnt[e0], 1, __ATOMIC_RELAXED, __HIP_MEMORY_SCOPE_WORKGROUP), l1 = __hip_atomic_fetch_add(&lcnt[e1], 1, __ATOMIC_RELAXED, __HIP_MEMORY_SCOPE_WORKGROUP);
                tiE[2 * tt] = e0; tiE[2 * tt + 1] = e1; tiL[2 * tt] = l0; tiL[2 * tt + 1] = l1; tiW[2 * tt] = w0; tiW[2 * tt + 1] = w1; tiR[tt] = rs; }
        }
        __syncthreads();
        if (tid < 8) lbase[tid] = (int)__hip_atomic_fetch_add(gcnt + tid, (unsigned)lcnt[tid], __ATOMIC_RELAXED, __HIP_MEMORY_SCOPE_AGENT);
        __syncthreads();
        if (tid < 128) { const int tt = tid >> 1, e = tiE[tid], idx = lbase[e] + tiL[tid], tok = chunk * 64 + tt;
            if (idx < 16384) { tok_e[e * 16384 + idx] = tok; gw_e[e * 16384 + idx] = tiW[tid]; rs_e[e * 16384 + idx] = tiR[tt]; }
            pos[2 * tok + (tid & 1)] = (e << 16) | idx; }
        __syncthreads();
    }
}
__device__ __forceinline__ void l1_combine(Frame& F, const Args& a) {
    int tid_ = threadIdx.x; asm volatile("" : "+v"(tid_)); const int tid = tid_, lane = tid & 63, wave = __builtin_amdgcn_readfirstlane(tid >> 6); (void)lane; (void)wave;
    const int gw = blockIdx.x * NWAVES + wave, NGW = F.G * NWAVES;
    const int* cntp = (const int*)(F.ctl + CW_ECNT); const int* pos = (const int*)(F.ws + WS_POS);
    pg8::MoeTiles T; T.init(cntp);
    const bf16* Y = (const bf16*)(F.ws + R_Y); bf16* XB = (bf16*)(F.ws + WS_XBA); float* ssq = (float*)(F.ws + WS_SSQA);
    for (int tok = gw; tok < M; tok += NGW) {
        const int p0 = pos[2 * tok], p1 = pos[2 * tok + 1];
        const int b0 = T.base_of(p0 >> 16), b1 = T.base_of(p1 >> 16);
        const size_t r0 = (size_t)b0 * 256 + (p0 & 0xffff), r1 = (size_t)b1 * 256 + (p1 & 0xffff);
        GAS f32x4* hr = (GAS f32x4*)(F.H + (size_t)tok * D) + lane;
        const GAS v2u* y0 = (const GAS v2u*)(Y + r0 * D) + lane; const GAS v2u* y1 = (const GAS v2u*)(Y + r1 * D) + lane;
        GAS v2u* xo = (GAS v2u*)(XB + (size_t)tok * D) + lane;
        float s = 0.f;
#pragma unroll
        for (int j = 0; j < 4; ++j) { f32x4 h = hr[64 * j]; const v2u a0 = y0[64 * j], a1 = y1[64 * j];
            h.x += bflo(a0.x) + bflo(a1.x); h.y += bfhi(a0.x) + bfhi(a1.x); h.z += bflo(a0.y) + bflo(a1.y); h.w += bfhi(a0.y) + bfhi(a1.y);
            hr[64 * j] = h; v2u w; w.x = pk2(h.x, h.y); w.y = pk2(h.z, h.w); xo[64 * j] = w;
            s += (h.x * h.x + h.y * h.y) + (h.z * h.z + h.w * h.w); }
        s = wave_sum(s);
        if (lane == 0) *(GAS f32x4*)(ssq + 4 * (size_t)tok) = (f32x4){s, 0.f, 0.f, 0.f};
    }
    cvt_f32_bf16_flat(a.in[1] + (size_t)M * PLE, (bf16*)(F.ws + R_PB1), (size_t)M * PLE / 8, blockIdx.x * (NWAVES * 64) + tid, F.G * NWAVES * 64);
}
__device__ __forceinline__ void final_norm(Frame& F, const Args& a) {
    int tid_ = threadIdx.x; asm volatile("" : "+v"(tid_)); const int tid = tid_, lane = tid & 63, wave = __builtin_amdgcn_readfirstlane(tid >> 6); (void)lane; (void)wave;
    const int gw = blockIdx.x * NWAVES + wave, NGW = F.G * NWAVES;
    const float* ssq = (const float*)(F.ws + WS_SSQB); const float* g = a.in[3];
    f32x4 gv[4];
#pragma unroll
    for (int j = 0; j < 4; ++j) gv[j] = ((const GAS f32x4*)g)[64 * j + lane];
    for (int tok = gw; tok < M; tok += NGW) {
        const float rs = pg8::rstd_of(ssq, tok);
        GAS f32x4* hr = (GAS f32x4*)(F.H + (size_t)tok * D) + lane;
#pragma unroll
        for (int j = 0; j < 4; ++j) { f32x4 h = hr[64 * j]; h = h * rs * gv[j]; hr[64 * j] = h; }
    }
}

constexpr int N_PHASES = 19;
__global__ void __launch_bounds__(NWAVES * 64, 2) trunk_fwd(Args args) {
    extern __shared__ __attribute__((aligned(16))) unsigned char lds[];
    Frame F;
    F.lds = (LAS unsigned char*)lds;
    F.MISC = (volatile LAS unsigned*)(F.lds + MISC_OFF);
    F.G = gridDim.x;
    F.ws = args.ws; F.ctl = (gu32*)(args.ws + WS_CTL); F.H = args.out;
    unsigned char* ws = args.ws;
    for (int u = threadIdx.x; u < (LDS_BYTES - LDSCTL_OFF) / 4; u += NWAVES * 64) ((LAS unsigned*)(F.lds + LDSCTL_OFF))[u] = 0u;
    __syncthreads();
    XcdBarrier bar; bar.bar = (unsigned*)(F.ctl + CW_BAR); bar.x = 0; bar.st = nullptr;
    const int lo = args.ph_lo, hi = args.ph_hi;
    if (hi - lo > 1) bar = xcd_barrier_post((unsigned*)(F.ctl + CW_BAR), F.MISC + 8);
#define IN(k) (lo <= (k) && (k) < hi)
#define SEAM(k) do { if (IN(k) && IN((k) + 1)) xcd_barrier(bar); } while (0)
    const int bx = (int)blockIdx.x;
    float* SSQA = (float*)(ws + WS_SSQA); float* SSQB = (float*)(ws + WS_SSQB);
    bf16* XBA = (bf16*)(ws + WS_XBA); bf16* XBB = (bf16*)(ws + R_XBB);

    if (IN(0)) { p0_prologue(F, args); } SEAM(0);
    if (IN(1)) { pg8::Gemm g{XBA, (const bf16*)(ws + W_IN), D, 0}; pg8::StaticOrder S; S.init(M, DIN0, F.G, bx);
        pg8::EpiScaleBf16 E{(bf16*)(ws + R_Z), DIN0, SSQA, 0, 0, ZC_Q / 256, ZC_K / 256, SWA_C2};
        pg8::gemm_phase<pg8::EpiScaleBf16, pg8::StaticOrder, true, true, false>(F.lds, g, S, E); } SEAM(1);
    if (IN(2)) { l0_mixer_naive(F, args); } SEAM(2);
    if (IN(3)) { pg8::Gemm g{(const bf16*)(ws + R_MIX), (const bf16*)(ws + W_OUT), D, 0}; pg8::StaticOrder S; S.init(M, D, F.G, bx);
        pg8::EpiRes<false> E{args.in[0], F.H, XBA, SSQB, nullptr, nullptr};
        pg8::gemm_phase<pg8::EpiRes<false>, pg8::StaticOrder, false, true, false>(F.lds, g, S, E); } SEAM(3);
    if (IN(4)) { pg8::Gemm g{XBA, (const bf16*)(ws + W_GU0), D, 0}; pg8::StaticOrder S; S.init(M, 2 * DFF0, F.G, bx);
        pg8::EpiSwiGLU<false> E{(bf16*)(ws + R_HM0), DFF0, SSQB};
        pg8::gemm_phase<pg8::EpiSwiGLU<false>, pg8::StaticOrder, true, true, false>(F.lds, g, S, E); } SEAM(4);
    if (IN(5)) { pg8::Gemm g{(const bf16*)(ws + R_HM0), (const bf16*)(ws + W_D0), DFF0, 0}; pg8::StaticOrder S; S.init(M, D, F.G, bx);
        pg8::EpiRes<false> E{F.H, F.H, XBA, SSQA, nullptr, nullptr};
        pg8::gemm_phase<pg8::EpiRes<false>, pg8::StaticOrder, false, true, false>(F.lds, g, S, E); } SEAM(5);
    if (IN(6)) {
        { pg8::Gemm g{(const bf16*)(ws + R_PB0), (const bf16*)(ws + W_PP0), PLE, 0}; pg8::StaticOrder S; S.init(M, D, F.G, bx);
          pg8::EpiPP E{(bf16*)(ws + R_PP)};
          pg8::gemm_phase<pg8::EpiPP, pg8::StaticOrder, false, true, false>(F.lds, g, S, E); }
        { pg8::Gemm g{XBA, (const bf16*)(ws + W_PG0), D, 0}; pg8::StaticOrder S; S.init(M, D, F.G, bx);
          pg8::EpiRes<true> E{F.H, F.H, XBB, SSQB, SSQA, (const bf16*)(ws + R_PP)};
          pg8::gemm_phase<pg8::EpiRes<true>, pg8::StaticOrder, false, true, false>(F.lds, g, S, E); }
    } SEAM(6);
    if (IN(7)) { pg8::Gemm g{XBB, (const bf16*)(ws + W_QKV), D, 0}; pg8::StaticOrder S; S.init(M, 3 * D, F.G, bx);
        pg8::EpiScaleBf16 E{(bf16*)(ws + R_Q), D, SSQB, D, (size_t)(R_K - R_Q) / 2, 0, 4, MOBA_C2};
        pg8::gemm_phase<pg8::EpiScaleBf16, pg8::StaticOrder, true, true, false>(F.lds, g, S, E); } SEAM(7);
    if (IN(8)) { l1_kmean(F); } SEAM(8);
    if (IN(9)) { l1_moba_select(F); } SEAM(9);
    if (IN(10)) { l1_moba_partial(F, args); } SEAM(10);
    if (IN(11)) { l1_moba_own_merge(F, args); } SEAM(11);
    if (IN(12)) { pg8::Gemm g{(const bf16*)(ws + R_ATT), (const bf16*)(ws + W_O), D, 0}; pg8::StaticOrder S; S.init(M, D, F.G, bx);
        pg8::EpiRes<false> E{F.H, F.H, XBA, nullptr, nullptr, nullptr};
        pg8::gemm_phase<pg8::EpiRes<false>, pg8::StaticOrder, false, true, false>(F.lds, g, S, E); } SEAM(12);
    if (IN(13)) { l1_route(F, args); } SEAM(13);
    if (IN(14)) { pg8::Gemm g{XBA, (const bf16*)(ws + W_EGU), D, (size_t)2 * DFE * D}; pg8::MoeOrder S; S.init((const int*)(F.ctl + CW_ECNT), 2 * DFE / 256, F.G, bx, (const int*)(ws + WS_TOKE));
        pg8::EpiSwiGLU<true> E{(bf16*)(ws + R_HMG), DFE, (const float*)(ws + WS_RSE)};
        pg8::gemm_phase<pg8::EpiSwiGLU<true>, pg8::MoeOrder, true, true, true>(F.lds, g, S, E); } SEAM(14);
    if (IN(15)) { pg8::Gemm g{(const bf16*)(ws + R_HMG), (const bf16*)(ws + W_ED), DFE, (size_t)D * DFE}; pg8::MoeOrder S; S.init((const int*)(F.ctl + CW_ECNT), D / 256, F.G, bx, nullptr);
        pg8::EpiMoeDown E{(bf16*)(ws + R_Y), (const float*)(ws + WS_GWE)};
        pg8::gemm_phase<pg8::EpiMoeDown, pg8::MoeOrder, true, true, false>(F.lds, g, S, E); } SEAM(15);
    if (IN(16)) { l1_combine(F, args); } SEAM(16);
    if (IN(17)) {
        { pg8::Gemm g{(const bf16*)(ws + R_PB1), (const bf16*)(ws + W_PP1), PLE, 0}; pg8::StaticOrder S; S.init(M, D, F.G, bx);
          pg8::EpiPP E{(bf16*)(ws + R_PP1)};
          pg8::gemm_phase<pg8::EpiPP, pg8::StaticOrder, false, true, false>(F.lds, g, S, E); }
        { pg8::Gemm g{XBA, (const bf16*)(ws + W_PG1), D, 0}; pg8::StaticOrder S; S.init(M, D, F.G, bx);
          pg8::EpiRes<true> E{F.H, F.H, nullptr, SSQB, SSQA, (const bf16*)(ws + R_PP1)};
          pg8::gemm_phase<pg8::EpiRes<true>, pg8::StaticOrder, false, true, false>(F.lds, g, S, E); }
    } SEAM(17);
    if (IN(18)) { final_norm(F, args); }
#undef IN
#undef SEAM
}

extern "C" void kernel_launch(void* const* d_in, const int* in_sizes, int n_in, void* d_out, int out_size, void* d_ws, size_t ws_size, hipStream_t stream) {
    static int grid = 0;
    if (grid == 0) {
        if (n_in != 27 || in_sizes[0] != M * D || out_size != M * D || ws_size < WS_END) { fprintf(stderr, "kernel_launch: unexpected problem (n_in %d, in0 %d, out %d, ws %zu < %zu); nothing launched\n", n_in, n_in > 0 ? in_sizes[0] : -1, out_size, ws_size, (size_t)WS_END); grid = -1; return; }
        int dev = 0, cus = 0, per_cu = 0;
        if (hipGetDevice(&dev) != hipSuccess || hipDeviceGetAttribute(&cus, hipDeviceAttributeMultiprocessorCount, dev) != hipSuccess) { grid = -1; return; }
        if (hipFuncSetAttribute((const void*)trunk_fwd, hipFuncAttributeMaxDynamicSharedMemorySize, LDS_BYTES) != hipSuccess) { fprintf(stderr, "kernel_launch: hipFuncSetAttribute failed\n"); grid = -1; return; }
        if (hipOccupancyMaxActiveBlocksPerMultiprocessor(&per_cu, (const void*)trunk_fwd, NWAVES * 64, LDS_BYTES) != hipSuccess || per_cu < 1) fprintf(stderr, "kernel_launch: occupancy query reports %d\n", per_cu);
        (void)hipGetLastError();
        grid = cus;
        if (grid != 256) { fprintf(stderr, "kernel_launch: built for 256 CUs, found %d; nothing launched\n", cus); grid = -1; return; }
    }
    if (grid < 0) return;
    if (hipMemsetAsync((char*)d_ws + WS_CTL, 0, CTL_ZERO_BYTES, stream) != hipSuccess) return;
    Args a{};
    for (int i = 0; i < 27; ++i) a.in[i] = (const float*)d_in[i];
    a.out = (float*)d_out; a.ws = (unsigned char*)d_ws;
#if MK_ONE_LAUNCH
    a.ph_lo = 0; a.ph_hi = N_PHASES;
    hipLaunchKernelGGL(trunk_fwd, dim3(grid), dim3(NWAVES * 64), LDS_BYTES, stream, a);
#else
    for (int ph = 0; ph < N_PHASES; ++ph) { a.ph_lo = ph; a.ph_hi = ph + 1; hipLaunchKernelGGL(trunk_fwd, dim3(grid), dim3(NWAVES * 64), LDS_BYTES, stream, a); }
#endif
}
```

```cpp
#include <hip/hip_runtime.h>
#include <cstdio>
#include <cstdint>

#ifndef PROBE_PHASE
#define PROBE_PHASE (-1)
#define PROBE_CNT 1
#endif
#ifndef MK_ONE_LAUNCH
#define MK_ONE_LAUNCH 1
#endif

namespace pg8 {
#define PG8_LAS __attribute__((address_space(3)))
typedef unsigned short bf16_t;
typedef short bf16x8 __attribute__((ext_vector_type(8)));
typedef float f32x4 __attribute__((ext_vector_type(4)));
typedef float f32x2 __attribute__((ext_vector_type(2)));
typedef unsigned u32x4 __attribute__((ext_vector_type(4)));
typedef unsigned u32x2 __attribute__((ext_vector_type(2)));
constexpr int BM = 256, BK = 64, HALF = 128, HTB = HALF * BK * 2, STAGE_BYTES = 8 * HTB, NXCD = 8, WGM = 8;

__host__ __device__ __forceinline__ int lds_byte(int r, int c) { const int st = (r >> 4) * 2 + (c >> 5), rr = r & 15, cc = c & 31, ob = rr * 64 + cc * 2; return st * 1024 + (ob ^ (((ob >> 9) & 1) << 5)); }
__host__ __device__ __forceinline__ void stage_rc(int b, int& R, int& C) { const int st = b / 1024, sb = b % 1024, swz = sb ^ (((sb >> 9) & 1) << 5); R = (st >> 1) * 16 + swz / 64; C = (st & 1) * 32 + (swz % 64) / 2; }
__host__ __device__ __forceinline__ int perm32(int rho) { const int n = rho >> 4, i = rho & 15; return 8 * (i >> 2) + 4 * n + (i & 3); }

struct Unit { int pm, pn, e, mt, nv, kc; };
struct Gemm { const bf16_t* A; const bf16_t* Bt; int K; size_t bslab; int ld; };

__device__ __forceinline__ void map_tile(int L, int nwg, int nM, int nN, int& pm, int& pn) {
    int wgid = L; { const int q = nwg / NXCD, r = nwg % NXCD, xcd = wgid % NXCD, off = wgid / NXCD; wgid = (xcd < r ? xcd * (q + 1) : r * (q + 1) + (xcd - r) * q) + off; }
    const int nig = WGM * nN, gid = wgid / nig, fm = gid * WGM, gsz = (nM - fm) < WGM ? (nM - fm) : WGM;
    pm = fm + ((wgid % nig) % gsz); pn = (wgid % nig) / gsz;
}
struct StaticOrder {
    int nM, nN, nwg, G, c;
    __device__ __forceinline__ void init(int M, int N, int G_, int c_) { nM = M / BM; nN = N / BM; nwg = nM * nN; G = G_; c = c_; }
    __device__ __forceinline__ bool next(int i, Unit& u) const {
        const long L = (long)i * G + c; if (L >= nwg) return false;
        map_tile((int)L, nwg, nM, nN, u.pm, u.pn); u.e = 0; u.mt = u.pm; u.nv = 256; u.kc = 0; return true;
    }
    __device__ __forceinline__ int arow(const Unit& u, int r) const { return u.pm * BM + r; }
};
struct MoeTiles {
    int c0, c1, c2, c3, c4, c5, c6, c7, t1, t2, t3, t4, t5, t6, t7, t8;
    __device__ __forceinline__ static int clampc(int v) { return v < 0 ? 0 : (v > 16384 ? 16384 : v); }
    __device__ __forceinline__ void init(const int* cntp) {
        c0 = clampc(cntp[0]); c1 = clampc(cntp[1]); c2 = clampc(cntp[2]); c3 = clampc(cntp[3]); c4 = clampc(cntp[4]); c5 = clampc(cntp[5]); c6 = clampc(cntp[6]); c7 = clampc(cntp[7]);
        t1 = (c0 + 255) >> 8; t2 = t1 + ((c1 + 255) >> 8); t3 = t2 + ((c2 + 255) >> 8); t4 = t3 + ((c3 + 255) >> 8); t5 = t4 + ((c4 + 255) >> 8); t6 = t5 + ((c5 + 255) >> 8); t7 = t6 + ((c6 + 255) >> 8); t8 = t7 + ((c7 + 255) >> 8);
    }
    __device__ __forceinline__ int base_of(int e) const { return e == 0 ? 0 : e == 1 ? t1 : e == 2 ? t2 : e == 3 ? t3 : e == 4 ? t4 : e == 5 ? t5 : e == 6 ? t6 : t7; }
    __device__ __forceinline__ int cnt_of(int e) const { return e == 0 ? c0 : e == 1 ? c1 : e == 2 ? c2 : e == 3 ? c3 : e == 4 ? c4 : e == 5 ? c5 : e == 6 ? c6 : c7; }
    __device__ __forceinline__ int expert_of(int pm) const { return (pm >= t1) + (pm >= t2) + (pm >= t3) + (pm >= t4) + (pm >= t5) + (pm >= t6) + (pm >= t7); }
};
struct MoeOrder {
    MoeTiles T; int nN, nwg, G, c, nM; const int* tok;
    __device__ __forceinline__ void init(const int* cntp, int nN_, int G_, int c_, const int* tok_, int lim_sub) { T.init(cntp); int nl = T.t8 - 128; nl = nl < 0 ? 0 : (nl > lim_sub ? lim_sub : nl); nM = T.t8 - nl; nN = nN_; nwg = nM * nN_; G = G_; c = c_; tok = tok_; }
    __device__ __forceinline__ void fill(Unit& u) const { const int e = T.expert_of(u.pm); u.e = e; u.mt = u.pm - T.base_of(e); const int rem = T.cnt_of(e) - u.mt * 256; u.nv = rem > 256 ? 256 : rem; }
    __device__ __forceinline__ bool next(int i, Unit& u) const {
        const long L = (long)i * G + c; if (L >= nwg) return false;
        map_tile((int)L, nwg, nM, nN, u.pm, u.pn); u.kc = 0; fill(u); return true;
    }
    __device__ __forceinline__ int arow(const Unit& u, int r) const { return r < u.nv ? tok[u.e * 16384 + u.mt * 256 + r] : 0; }
};
struct MoeSubOrder {
    MoeOrder O; int nsub, nkc;
    __device__ __forceinline__ void init(const int* cntp, int nN_, int G_, int c_, int lim_sub, int nkc_) { O.init(cntp, nN_, G_, c_, nullptr, lim_sub); nkc = nkc_; nsub = (O.T.t8 - O.nM) * nN_ * nkc_; }
    __device__ __forceinline__ bool next(int i, Unit& u) const {
        const long L = (long)i * O.G + O.c; if (L >= nsub) return false;
        const int l = (int)L; u.kc = l % nkc; const int r = l / nkc; u.pn = r % O.nN; u.pm = O.nM + r / O.nN; O.fill(u); return true;
    }
    __device__ __forceinline__ int arow(const Unit& u, int r) const { return 0; }
};

__device__ __forceinline__ unsigned cvt_pk_bf16(float lo, float hi) { unsigned r; asm volatile("v_cvt_pk_bf16_f32 %0, %1, %2" : "=v"(r) : "v"(lo), "v"(hi)); return r; }
__device__ __forceinline__ float rstd_of(const float* ssq4, int row) { const f32x4 s = *(const f32x4*)(ssq4 + 4 * (size_t)row); return rsqrtf(((s[0] + s[1]) + (s[2] + s[3])) * (1.0f / 1024.0f) + 1e-6f); }
__device__ __forceinline__ float rstd_from(const f32x4 s) { return rsqrtf(((s[0] + s[1]) + (s[2] + s[3])) * (1.0f / 1024.0f) + 1e-6f); }
__device__ __forceinline__ float silu_f(float x) { return x * __builtin_amdgcn_rcpf(1.0f + __expf(-x)); }
__device__ __forceinline__ float sigmoid_f(float x) { return __builtin_amdgcn_rcpf(1.0f + __expf(-x)); }

struct EpiScaleBf16 {
    static constexpr bool PERM = true, AFTER_DRAIN = false;
    bf16_t* O; int ldc; const float* ssq4; int split_cols; size_t split_stride; int sc_lo, sc_hi; float scale0;
    __device__ __forceinline__ void operator()(const f32x4 (&acc)[2][2][4][2], const Unit& u, int wr, int wc, int fr, int fq) const {
        const int row0 = u.pm * BM + wr * 64 + fr; int colt = u.pn * BM; bf16_t* base = O; const float sc = (u.pn >= sc_lo && u.pn < sc_hi) ? scale0 : 1.f;
        if (split_cols) { const int t = colt / split_cols; base += (size_t)t * split_stride; colt -= t * split_cols; }
        const int col0 = colt + wc * 32 + 8 * fq;
        f32x4 sq[2][4];
#pragma unroll
        for (int ai = 0; ai < 2; ++ai)
#pragma unroll
            for (int m = 0; m < 4; ++m) sq[ai][m] = *(const f32x4*)(ssq4 + 4 * (size_t)(row0 + ai * HALF + m * 16));
#pragma unroll
        for (int ai = 0; ai < 2; ++ai)
#pragma unroll
            for (int m = 0; m < 4; ++m) { const int row = row0 + ai * HALF + m * 16; const float rs = rstd_from(sq[ai][m]) * sc; bf16_t* rowp = base + (size_t)row * ldc + col0;
#pragma unroll
                for (int bj = 0; bj < 2; ++bj) { const f32x4 v0 = acc[ai][bj][m][0] * rs, v1 = acc[ai][bj][m][1] * rs;
                    u32x4 w; w.x = cvt_pk_bf16(v0[0], v0[1]); w.y = cvt_pk_bf16(v0[2], v0[3]); w.z = cvt_pk_bf16(v1[0], v1[1]); w.w = cvt_pk_bf16(v1[2], v1[3]);
                    *(u32x4*)(rowp + bj * HALF) = w; } }
    }
};
template <bool MOE> struct EpiSwiGLU {
    static constexpr bool PERM = true, AFTER_DRAIN = false;
    bf16_t* O; int ldo; const float* rs_src;
    __device__ __forceinline__ void operator()(const f32x4 (&acc)[2][2][4][2], const Unit& u, int wr, int wc, int fr, int fq) const {
        const int col0 = u.pn * HALF + wc * 32 + 8 * fq;
        float rsv[2][4];
#pragma unroll
        for (int ai = 0; ai < 2; ++ai)
#pragma unroll
            for (int m = 0; m < 4; ++m) { const int rl = ai * HALF + wr * 64 + m * 16 + fr;
                if (MOE) rsv[ai][m] = rl < u.nv ? rs_src[u.e * 16384 + u.mt * 256 + rl] : 0.f;
                else { const f32x4 s = *(const f32x4*)(rs_src + 4 * (size_t)(u.pm * BM + rl)); rsv[ai][m] = ((s[0] + s[1]) + (s[2] + s[3])); } }
#pragma unroll
        for (int ai = 0; ai < 2; ++ai)
#pragma unroll
            for (int m = 0; m < 4; ++m) { const int rl = ai * HALF + wr * 64 + m * 16 + fr; const int row = u.pm * BM + rl;
                const float rs = MOE ? rsv[ai][m] : rsqrtf(rsv[ai][m] * (1.0f / 1024.0f) + 1e-6f);
                const f32x4 g0 = acc[ai][0][m][0] * rs, g1 = acc[ai][0][m][1] * rs, u0 = acc[ai][1][m][0] * rs, u1 = acc[ai][1][m][1] * rs;
                u32x4 w;
                w.x = cvt_pk_bf16(silu_f(g0[0]) * u0[0], silu_f(g0[1]) * u0[1]); w.y = cvt_pk_bf16(silu_f(g0[2]) * u0[2], silu_f(g0[3]) * u0[3]);
                w.z = cvt_pk_bf16(silu_f(g1[0]) * u1[0], silu_f(g1[1]) * u1[1]); w.w = cvt_pk_bf16(silu_f(g1[2]) * u1[2], silu_f(g1[3]) * u1[3]);
                *(u32x4*)(O + (size_t)row * ldo + col0) = w; }
    }
};
struct EpiMoeDown {
    static constexpr bool PERM = true, AFTER_DRAIN = false;
    bf16_t* Y; const float* gw;
    __device__ __forceinline__ void operator()(const f32x4 (&acc)[2][2][4][2], const Unit& u, int wr, int wc, int fr, int fq) const {
        const int col0 = u.pn * BM + wc * 32 + 8 * fq;
        float gv[2][4];
#pragma unroll
        for (int ai = 0; ai < 2; ++ai)
#pragma unroll
            for (int m = 0; m < 4; ++m) { const int rl = ai * HALF + wr * 64 + m * 16 + fr; gv[ai][m] = rl < u.nv ? gw[u.e * 16384 + u.mt * 256 + rl] : 0.f; }
#pragma unroll
        for (int ai = 0; ai < 2; ++ai)
#pragma unroll
            for (int m = 0; m < 4; ++m) { const int rl = ai * HALF + wr * 64 + m * 16 + fr; const int row = u.pm * BM + rl;
                const float g = gv[ai][m];
#pragma unroll
                for (int bj = 0; bj < 2; ++bj) { const f32x4 v0 = acc[ai][bj][m][0] * g, v1 = acc[ai][bj][m][1] * g;
                    u32x4 w; w.x = cvt_pk_bf16(v0[0], v0[1]); w.y = cvt_pk_bf16(v0[2], v0[3]); w.z = cvt_pk_bf16(v1[0], v1[1]); w.w = cvt_pk_bf16(v1[2], v1[3]);
                    *(u32x4*)(Y + (size_t)row * 1024 + col0 + bj * HALF) = w; } }
    }
};
struct EpiMoePartial {
    static constexpr bool PERM = false, AFTER_DRAIN = false;
    float* YP; const float* gw; int pm0; size_t cstride;
    __device__ __forceinline__ void operator()(const f32x4 (&acc)[2][2][4][2], const Unit& u, int wr, int wc, int fr, int fq) const {
        const int col0 = u.pn * BM + wc * 32 + 4 * fq;
        float gv[2][4];
#pragma unroll
        for (int ai = 0; ai < 2; ++ai)
#pragma unroll
            for (int m = 0; m < 4; ++m) { const int rl = ai * HALF + wr * 64 + m * 16 + fr; gv[ai][m] = rl < u.nv ? gw[u.e * 16384 + u.mt * 256 + rl] : 0.f; }
        float* base = YP + (size_t)u.kc * cstride;
#pragma unroll
        for (int ai = 0; ai < 2; ++ai)
#pragma unroll
            for (int m = 0; m < 4; ++m) { const size_t off = (size_t)((u.pm - pm0) * BM + ai * HALF + wr * 64 + m * 16 + fr) * 1024 + col0;
#pragma unroll
                for (int bj = 0; bj < 2; ++bj)
#pragma unroll
                    for (int n = 0; n < 2; ++n) *(f32x4*)(base + off + bj * HALF + n * 16) = acc[ai][bj][m][n] * gv[ai][m]; }
    }
};
struct EpiPP {
    static constexpr bool PERM = false, AFTER_DRAIN = false;
    bf16_t* O;
    __device__ __forceinline__ void operator()(const f32x4 (&acc)[2][2][4][2], const Unit& u, int wr, int wc, int fr, int fq) const {
        const int col0 = u.pn * BM + wc * 32 + 4 * fq;
#pragma unroll
        for (int ai = 0; ai < 2; ++ai)
#pragma unroll
            for (int m = 0; m < 4; ++m) { const size_t off = (size_t)(u.pm * BM + ai * HALF + wr * 64 + m * 16 + fr) * 1024 + col0;
#pragma unroll
                for (int bj = 0; bj < 2; ++bj)
#pragma unroll
                    for (int n = 0; n < 2; ++n) { const f32x4 v = acc[ai][bj][m][n]; u32x2 w; w.x = cvt_pk_bf16(v[0], v[1]); w.y = cvt_pk_bf16(v[2], v[3]); *(u32x2*)(O + off + bj * HALF + n * 16) = w; } }
    }
};
template <bool PLE> struct EpiRes {
    static constexpr bool PERM = false, AFTER_DRAIN = true;
    static constexpr int NG = PLE ? 2 : 4, NB = 8 / NG;
    const float* Hin; float* Hout; bf16_t* XB; float* ssq_out; const float* ssq_in; const bf16_t* PP;
    struct Pre { f32x4 h[NG][2][2]; u32x2 p[PLE ? NG : 1][2][2]; f32x4 sq[PLE ? NG : 1]; };
    __device__ __forceinline__ void preload(Pre& r, const Unit& u, int bt, int wr, int wc, int fr, int fq) const {
        const int col0 = u.pn * BM + wc * 32 + 4 * fq;
#pragma unroll
        for (int gi = 0; gi < NG; ++gi) { const int gm = bt * NG + gi, ai = gm >> 2, m = gm & 3; const int row = u.pm * BM + ai * HALF + wr * 64 + m * 16 + fr; const size_t off = (size_t)row * 1024 + col0;
            if (PLE) r.sq[gi] = *(const f32x4*)(ssq_in + 4 * (size_t)row);
#pragma unroll
            for (int bj = 0; bj < 2; ++bj)
#pragma unroll
                for (int n = 0; n < 2; ++n) { r.h[gi][bj][n] = *(const f32x4*)(Hin + off + bj * HALF + n * 16); if (PLE) r.p[gi][bj][n] = *(const u32x2*)(PP + off + bj * HALF + n * 16); } }
    }
    __device__ __forceinline__ void fused(f32x4 (&acc)[2][2][4][2], Pre& r, const Unit& u, int wr, int wc, int fr, int fq, PG8_LAS unsigned char* lds, int wid, int lane) const {
        PG8_LAS float* P = (PG8_LAS float*)lds;
        const int col0 = u.pn * BM + wc * 32 + 4 * fq;
#pragma unroll
        for (int bt = 0; bt < NB; ++bt) {
            if (bt > 0) preload(r, u, bt, wr, wc, fr, fq);
#pragma unroll
            for (int gi = 0; gi < NG; ++gi) { const int gm = bt * NG + gi, ai = gm >> 2, m = gm & 3;
                const int rl = ai * HALF + wr * 64 + m * 16 + fr; const int row = u.pm * BM + rl; const size_t off = (size_t)row * 1024 + col0;
                float rs = 0.f; if (PLE) rs = rstd_from(r.sq[gi]);
                float s = 0.f;
#pragma unroll
                for (int bj = 0; bj < 2; ++bj)
#pragma unroll
                    for (int n = 0; n < 2; ++n) { const size_t c = off + bj * HALF + n * 16; const f32x4 hin = r.h[gi][bj][n]; f32x4 v = acc[ai][bj][m][n];
                        if (PLE) { const u32x2 pw = r.p[gi][bj][n];
                            const float p0 = __uint_as_float(pw.x << 16), p1 = __uint_as_float(pw.x & 0xffff0000u), p2 = __uint_as_float(pw.y << 16), p3 = __uint_as_float(pw.y & 0xffff0000u);
                            v[0] = hin[0] + sigmoid_f(v[0] * rs) * p0; v[1] = hin[1] + sigmoid_f(v[1] * rs) * p1; v[2] = hin[2] + sigmoid_f(v[2] * rs) * p2; v[3] = hin[3] + sigmoid_f(v[3] * rs) * p3;
                        } else v = hin + v;
                        *(f32x4*)(Hout + c) = v;
                        if (XB) { u32x2 w; w.x = cvt_pk_bf16(v[0], v[1]); w.y = cvt_pk_bf16(v[2], v[3]); *(u32x2*)(XB + c) = w; }
                        s += (v[0] * v[0] + v[1] * v[1]) + (v[2] * v[2] + v[3] * v[3]); }
                s += __shfl_xor(s, 16); s += __shfl_xor(s, 32);
                if (ssq_out && fq == 0) P[rl * 4 + wc] = s; }
            asm volatile("" ::: "memory");
        }
        if (ssq_out) {
            asm volatile("s_waitcnt lgkmcnt(0)" ::: "memory"); __builtin_amdgcn_s_barrier(); asm volatile("" ::: "memory");
            const int t = wid * 64 + lane;
            if (t < 256) { const f32x4 q = *(const PG8_LAS f32x4*)(P + t * 4); ssq_out[(size_t)(u.pm * BM + t) * 4 + u.pn] = (q[0] + q[1]) + (q[2] + q[3]); }
            asm volatile("s_waitcnt lgkmcnt(0)" ::: "memory"); __builtin_amdgcn_s_barrier(); asm volatile("" ::: "memory");
        }
    }
};

template <class Epi, class Sched, bool ALIGN_EPI, bool SP2, bool GATHER>
__device__ __forceinline__ void gemm_phase(PG8_LAS unsigned char* lds, const Gemm g, const Sched& S, const Epi& E) {
    int tid_ = threadIdx.x; asm volatile("" : "+v"(tid_));
    const int tid = tid_, wid = __builtin_amdgcn_readfirstlane(tid >> 6), lane = tid & 63, wr = wid >> 2, wc = wid & 3, fr = lane & 15, fq = lane >> 4;
    const int K = g.K, nt = K / BK, LD = g.ld;
    unsigned voffA[2], voffB[2]; int aR[2], aC[2];
#pragma unroll
    for (int i = 0; i < 2; ++i) { int R, C; stage_rc(tid * 16 + i * 8192, R, C); const int Rb = Epi::PERM ? ((R & ~31) + perm32(R & 31)) : R;
        voffA[i] = (unsigned)(R * LD + C) * 2u; voffB[i] = (unsigned)(Rb * LD + C) * 2u; aR[i] = R; aC[i] = C; }
    const size_t kstep = (size_t)(BK * 2);
    const size_t hstep = (size_t)HALF * LD * 2;
    const size_t tstep = 2 * hstep;
    const unsigned ldsw = (unsigned)wid * 1024u;
    const int aoff = lds_byte(wr * 64 + fr, fq * 8), boff = lds_byte(wc * 32 + fr, fq * 8);
    unsigned gcur[2][2], gnxt[2][2];
#define PG8_SA(b, h) (((b) * 2 + (h)) * HTB)
#define PG8_SB(b, h) ((4 + (b) * 2 + (h)) * HTB)
#define PG8_STAGE(bufoff, gbase, voff) do { _Pragma("unroll") for (int _i = 0; _i < 2; ++_i) \
        __builtin_amdgcn_global_load_lds((const unsigned*)((const char*)(gbase) + (voff)[_i]), (PG8_LAS unsigned*)(lds + (bufoff) + ldsw + _i * 8192), 16, 0, 0); } while (0)
#define PG8_STAGE_A(bufoff, p, h, NX) do { if constexpr (GATHER) { unsigned _vo[2]; _vo[0] = (NX) ? gnxt[h][0] : gcur[h][0]; _vo[1] = (NX) ? gnxt[h][1] : gcur[h][1]; PG8_STAGE(bufoff, p, _vo); } \
        else { PG8_STAGE(bufoff, (p) + (h) * hstep, voffA); } } while (0)
#define PG8_GOFF(dst, uu) do { _Pragma("unroll") for (int _h = 0; _h < 2; ++_h) _Pragma("unroll") for (int _i = 0; _i < 2; ++_i) \
        dst[_h][_i] = ((unsigned)S.arow(uu, _h * HALF + aR[_i]) * (unsigned)LD + (unsigned)aC[_i]) * 2u; } while (0)
#define PG8_LDA(dst, b, h) do { _Pragma("unroll") for (int m = 0; m < 4; ++m) _Pragma("unroll") for (int k = 0; k < 2; ++k) dst[m][k] = *(const PG8_LAS bf16x8*)(lds + PG8_SA(b, h) + aoff + m * 2048 + k * 1024); } while (0)
#define PG8_LDB(dst, b, h) do { _Pragma("unroll") for (int n = 0; n < 2; ++n) _Pragma("unroll") for (int k = 0; k < 2; ++k) dst[n][k] = *(const PG8_LAS bf16x8*)(lds + PG8_SB(b, h) + boff + n * 2048 + k * 1024); } while (0)
#define PG8_MMA(ai, bj, At, Bt) do { __builtin_amdgcn_s_setprio(1); _Pragma("unroll") for (int m = 0; m < 4; ++m) _Pragma("unroll") for (int n = 0; n < 2; ++n) _Pragma("unroll") for (int k = 0; k < 2; ++k) \
        acc[ai][bj][m][n] = __builtin_amdgcn_mfma_f32_16x16x32_bf16(Bt[n][k], At[m][k], acc[ai][bj][m][n], 0, 0, 0); __builtin_amdgcn_s_setprio(0); } while (0)
#define PG8_WAIT_V(n) asm volatile("s_waitcnt vmcnt(" #n ")" ::: "memory")
#define PG8_WAIT_L(n) asm volatile("s_waitcnt lgkmcnt(" #n ")" ::: "memory")
#define PG8_BAR __builtin_amdgcn_s_barrier()
#define PG8_SCHED __builtin_amdgcn_sched_barrier(0)
    Unit cur, nxt; int ui = 0;
    if (!S.next(0, cur)) return;
    f32x4 acc[2][2][4][2];
#pragma unroll
    for (int a = 0; a < 2; ++a)
#pragma unroll
        for (int b = 0; b < 2; ++b)
#pragma unroll
            for (int m = 0; m < 4; ++m)
#pragma unroll
                for (int n = 0; n < 2; ++n) acc[a][b][m][n] = (f32x4){0.f, 0.f, 0.f, 0.f};
    bf16x8 At[4][2], B0[2][2], B1[2][2];
    const char* cA = GATHER ? (const char*)g.A : (const char*)g.A + (size_t)cur.pm * tstep + (size_t)cur.kc * K * 2;
    const char* cB = (const char*)g.Bt + ((size_t)cur.e * g.bslab) * 2 + (size_t)cur.pn * tstep + (size_t)cur.kc * K * 2;
    if constexpr (GATHER) { PG8_GOFF(gcur, cur); PG8_GOFF(gnxt, cur); }
    if constexpr (SP2) {
        PG8_STAGE(PG8_SB(0, 0), cB, voffB); PG8_STAGE(PG8_SB(0, 1), cB + hstep, voffB); PG8_STAGE_A(PG8_SA(0, 0), cA, 0, false); PG8_STAGE_A(PG8_SA(0, 1), cA, 1, false);
        if (wr == 1) PG8_BAR;
        PG8_WAIT_V(2); PG8_BAR;
        PG8_STAGE(PG8_SB(1, 0), cB + kstep, voffB); PG8_STAGE_A(PG8_SA(1, 0), cA + kstep, 0, false); PG8_STAGE(PG8_SB(1, 1), cB + hstep + kstep, voffB);
        PG8_WAIT_V(6); PG8_BAR;
    } else {
        PG8_STAGE(PG8_SB(0, 0), cB, voffB); PG8_STAGE_A(PG8_SA(0, 0), cA, 0, false); PG8_STAGE(PG8_SB(0, 1), cB + hstep, voffB); PG8_STAGE_A(PG8_SA(0, 1), cA, 1, false);
        if (wr == 1) PG8_BAR;
        PG8_WAIT_V(4); PG8_BAR;
        PG8_STAGE(PG8_SB(1, 0), cB + kstep, voffB); PG8_STAGE_A(PG8_SA(1, 0), cA + kstep, 0, false); PG8_STAGE(PG8_SB(1, 1), cB + hstep + kstep, voffB);
        PG8_WAIT_V(6); PG8_BAR;
    }
    for (;;) {
        const bool has_next = S.next(ui + 1, nxt);
        const char* nA = GATHER ? (const char*)g.A : (has_next ? (const char*)g.A + (size_t)nxt.pm * tstep + (size_t)nxt.kc * K * 2 : cA);
        const char* nB = has_next ? (const char*)g.Bt + ((size_t)nxt.e * g.bslab) * 2 + (size_t)nxt.pn * tstep + (size_t)nxt.kc * K * 2 : cB;
        if constexpr (GATHER) { if (has_next) { PG8_GOFF(gnxt, nxt); } else {
#pragma unroll
            for (int _h = 0; _h < 2; ++_h)
#pragma unroll
                for (int _i = 0; _i < 2; ++_i) gnxt[_h][_i] = gcur[_h][_i]; } }
        for (int t = 0; t < nt; t += 2) {
            const bool last = (t == nt - 2);
            const char* a1 = cA + (size_t)(t + 1) * kstep;
            const char* a2 = last ? nA : cA + (size_t)(t + 2) * kstep; const char* b2 = last ? nB : cB + (size_t)(t + 2) * kstep;
            const char* a3 = a2 + kstep; const char* b3 = b2 + kstep;
            if constexpr (SP2) {
            PG8_LDB(B0, 0, 0); PG8_LDB(B1, 0, 1); PG8_SCHED; PG8_LDA(At, 0, 0); PG8_STAGE_A(PG8_SA(1, 1), a1, 1, false);
            PG8_WAIT_V(8); PG8_WAIT_L(0); PG8_BAR; PG8_MMA(0, 0, At, B0); PG8_MMA(0, 1, At, B1); PG8_BAR; PG8_SCHED;
            PG8_LDA(At, 0, 1); PG8_STAGE(PG8_SB(0, 0), b2, voffB); PG8_STAGE(PG8_SB(0, 1), b2 + hstep, voffB); PG8_STAGE_A(PG8_SA(0, 0), a2, 0, last);
            PG8_WAIT_V(8); PG8_WAIT_L(0); PG8_BAR; PG8_MMA(1, 0, At, B0); PG8_MMA(1, 1, At, B1); PG8_BAR; PG8_SCHED;
            PG8_LDB(B0, 1, 0); PG8_LDB(B1, 1, 1); PG8_SCHED; PG8_LDA(At, 1, 0); PG8_STAGE_A(PG8_SA(0, 1), a2, 1, last);
            PG8_WAIT_V(8); PG8_WAIT_L(0); PG8_BAR; PG8_MMA(0, 0, At, B0); PG8_MMA(0, 1, At, B1); PG8_BAR; PG8_SCHED;
            PG8_LDA(At, 1, 1); PG8_STAGE(PG8_SB(1, 0), b3, voffB); PG8_STAGE(PG8_SB(1, 1), b3 + hstep, voffB); PG8_STAGE_A(PG8_SA(1, 0), a3, 0, last);
            PG8_WAIT_V(8); PG8_WAIT_L(0); PG8_BAR; PG8_MMA(1, 0, At, B0); PG8_MMA(1, 1, At, B1); PG8_BAR; PG8_SCHED;
            } else {
            PG8_LDB(B0, 0, 0); PG8_SCHED; PG8_LDA(At, 0, 0); PG8_STAGE_A(PG8_SA(1, 1), a1, 1, false);
            PG8_WAIT_L(8); PG8_BAR; PG8_WAIT_L(0); PG8_MMA(0, 0, At, B0); PG8_BAR; PG8_SCHED;
            PG8_LDB(B1, 0, 1); PG8_STAGE(PG8_SB(0, 0), b2, voffB);
            PG8_BAR; PG8_WAIT_L(0); PG8_MMA(0, 1, At, B1); PG8_BAR;
            PG8_LDA(At, 0, 1); PG8_STAGE_A(PG8_SA(0, 0), a2, 0, last);
            PG8_BAR; PG8_WAIT_L(0); PG8_MMA(1, 0, At, B0); PG8_BAR; PG8_SCHED;
            PG8_STAGE(PG8_SB(0, 1), b2 + hstep, voffB);
            PG8_WAIT_V(6); PG8_BAR; PG8_MMA(1, 1, At, B1); PG8_BAR;
            PG8_LDB(B0, 1, 0); PG8_SCHED; PG8_LDA(At, 1, 0); PG8_STAGE_A(PG8_SA(0, 1), a2, 1, last);
            PG8_WAIT_L(8); PG8_BAR; PG8_WAIT_L(0); PG8_MMA(0, 0, At, B0); PG8_BAR; PG8_SCHED;
            PG8_LDB(B1, 1, 1); PG8_STAGE(PG8_SB(1, 0), b3, voffB);
            PG8_BAR; PG8_WAIT_L(0); PG8_MMA(0, 1, At, B1); PG8_BAR;
            PG8_LDA(At, 1, 1); PG8_STAGE_A(PG8_SA(1, 0), a3, 0, last);
            PG8_BAR; PG8_WAIT_L(0); PG8_MMA(1, 0, At, B0); PG8_BAR; PG8_SCHED;
            PG8_STAGE(PG8_SB(1, 1), b3 + hstep, voffB);
            PG8_WAIT_V(6); PG8_BAR; PG8_MMA(1, 1, At, B1); PG8_BAR;
            }
        }
        if constexpr (ALIGN_EPI) { if (wr == 0) PG8_BAR; }
        if constexpr (!Epi::AFTER_DRAIN) { E(acc, cur, wr, wc, fr, fq); }
        if (!has_next) break;
#pragma unroll
        for (int a = 0; a < 2; ++a)
#pragma unroll
            for (int b = 0; b < 2; ++b)
#pragma unroll
                for (int m = 0; m < 4; ++m)
#pragma unroll
                    for (int n = 0; n < 2; ++n) acc[a][b][m][n] = (f32x4){0.f, 0.f, 0.f, 0.f};
        cur = nxt; cA = nA; cB = nB; ++ui;
        if constexpr (GATHER) {
#pragma unroll
            for (int _h = 0; _h < 2; ++_h)
#pragma unroll
                for (int _i = 0; _i < 2; ++_i) gcur[_h][_i] = gnxt[_h][_i]; }
        if constexpr (ALIGN_EPI) { if (wr == 1) PG8_BAR; }
    }
    if constexpr (Epi::AFTER_DRAIN) {
        typename Epi::Pre pre; E.preload(pre, cur, 0, wr, wc, fr, fq);
        PG8_WAIT_V(0);
        if constexpr (!ALIGN_EPI) { if (wr == 0) PG8_BAR; }
        PG8_BAR;
        E.fused(acc, pre, cur, wr, wc, fr, fq, lds, wid, lane);
    } else {
        PG8_WAIT_V(0);
        if constexpr (!ALIGN_EPI) { if (wr == 0) PG8_BAR; }
        PG8_BAR;
    }
#undef PG8_SA
#undef PG8_SB
#undef PG8_STAGE
#undef PG8_STAGE_A
#undef PG8_GOFF
#undef PG8_LDA
#undef PG8_LDB
#undef PG8_MMA
#undef PG8_WAIT_V
#undef PG8_WAIT_L
#undef PG8_BAR
#undef PG8_SCHED
}
}

constexpr int NWAVES = 8;
constexpr int BATCH = 2, SEQ = 8192, M = BATCH * SEQ, D = 1024;
constexpr int DIN0 = 2304, DFF0 = 2816, DFE = 3584, NEXP = 8, PLE = 256;
constexpr int ZC_B = 0, ZC_C = 512, ZC_U = 1024, ZC_Q = 1536, ZC_K = 2048, ZC_V = 2176;
constexpr int HMG_ROWS = 34816;
constexpr float EPS = 1e-6f;

constexpr size_t MiB = 1u << 20;
constexpr size_t WS_CTL = 0, CTL_ZERO_BYTES = 1 * MiB;
constexpr size_t WS_SSQA = 1 * MiB, WS_SSQB = WS_SSQA + 256 * 1024;
constexpr size_t WS_TOKE = 2 * MiB, WS_GWE = WS_TOKE + 512 * 1024, WS_RSE = WS_GWE + 512 * 1024, WS_POS = WS_RSE + 512 * 1024;
constexpr size_t WS_KM = 4 * MiB;
constexpr size_t WS_W = 16 * MiB;
constexpr size_t W_IN = WS_W, W_OUT = W_IN + (size_t)DIN0 * D * 2, W_GU0 = W_OUT + (size_t)D * D * 2, W_D0 = W_GU0 + (size_t)2 * DFF0 * D * 2,
                 W_PG0 = W_D0 + (size_t)D * DFF0 * 2, W_PP0 = W_PG0 + (size_t)D * D * 2, W_QKV = W_PP0 + (size_t)D * PLE * 2, W_O = W_QKV + (size_t)3 * D * D * 2,
                 W_PG1 = W_O + (size_t)D * D * 2, W_PP1 = W_PG1 + (size_t)D * D * 2, W_EGU = W_PP1 + (size_t)D * PLE * 2, W_ED = W_EGU + (size_t)NEXP * 2 * DFE * D * 2,
                 W_END = W_ED + (size_t)NEXP * D * DFE * 2;
constexpr size_t WS_XBA = 220 * MiB;
constexpr size_t WS_R = 252 * MiB;
static_assert(W_END <= WS_XBA, "weights overflow");
constexpr size_t R_Z = WS_R, R_MIX = WS_R + 72 * MiB, R_HM0 = WS_R, R_XBB = WS_R + 104 * MiB, R_PP = WS_R + 136 * MiB, R_PB0 = WS_R + 168 * MiB;
constexpr size_t R_Q = WS_R, R_K = WS_R + 32 * MiB, R_V = WS_R + 64 * MiB, R_PO = WS_R + 96 * MiB, R_ML = WS_R + 192 * MiB, R_LIST = WS_R + 196 * MiB, R_ATT = WS_R + 204 * MiB;
constexpr float MOBA_C2 = 0.08838834764831845f * 1.4426950408889634f;
constexpr float LOG2E = 1.4426950408889634f;
constexpr float SWA_C2 = 0.125f * 1.4426950408889634f;
constexpr size_t R_HMG = WS_R;
constexpr size_t R_Y = W_EGU;
constexpr size_t R_PB1 = WS_R, R_PP1 = WS_R + 8 * MiB;
constexpr int MOE_SUB_TILES = 6, MOE_NKC = 7;
constexpr size_t R_YP = R_Y + 68 * MiB;
static_assert(R_YP + (size_t)MOE_NKC * MOE_SUB_TILES * 256 * D * 4 <= W_ED, "YP overlay");
constexpr size_t WS_END = WS_R + 238 * MiB;
static_assert((size_t)HMG_ROWS * DFE * 2 <= 238 * MiB, "HMg");
static_assert((size_t)HMG_ROWS * D * 2 <= (size_t)NEXP * 2 * DFE * D * 2, "Y overlay");
constexpr int CW_BAR = 4096;
constexpr int CW_ECNT = 16384;
constexpr int CW_LCNT = 16384 + 64;

constexpr int RING_BYTES = 131072;
constexpr int LDS_BYTES = 147456;
constexpr int LDSCTL_OFF = LDS_BYTES - 1024, MISC_OFF = LDSCTL_OFF + 320;
static_assert(8 * 64 * 65 * 4 <= LDSCTL_OFF, "prologue scratch");

#define GAS __attribute__((address_space(1)))
#define LAS __attribute__((address_space(3)))
typedef unsigned short bf16;
typedef unsigned v4u __attribute__((ext_vector_type(4)));
typedef unsigned v2u __attribute__((ext_vector_type(2)));
typedef float f32x4 __attribute__((ext_vector_type(4)));
typedef GAS unsigned gu32;
#define RLX_AGENT __ATOMIC_RELAXED, __HIP_MEMORY_SCOPE_AGENT
#define LDS_WAIT() asm volatile("s_waitcnt lgkmcnt(0)" ::: "memory")
#define VM_WAIT() asm volatile("s_waitcnt vmcnt(0)" ::: "memory")
__device__ __forceinline__ unsigned pk2(float lo, float hi) { return pg8::cvt_pk_bf16(lo, hi); }
__device__ __forceinline__ float bflo(unsigned w) { return __uint_as_float(w << 16); }
__device__ __forceinline__ float bfhi(unsigned w) { return __uint_as_float(w & 0xffff0000u); }

#define XB_TMO      128
#define XB_XCNT(j)  (256  + 64 * (j))
#define XB_XSUB(j)  (1280 + 64 * (j))
#define XB_XGEN(j)  (2304 + 64 * (j))
#define XB_TOP      3328
#define XB_TOPGEN   3392
#define XCD_BAR_WORDS 3456
#define XB_SPIN_CAP (1u << 18)
__device__ __forceinline__ unsigned xb_ld(unsigned* p)              { return __hip_atomic_load(p, __ATOMIC_RELAXED, __HIP_MEMORY_SCOPE_AGENT); }
__device__ __forceinline__ unsigned xb_add(unsigned* p, unsigned v) { return __hip_atomic_fetch_add(p, v, __ATOMIC_RELAXED, __HIP_MEMORY_SCOPE_AGENT); }
__device__ __forceinline__ unsigned xb_xcc_id() { return (unsigned)__builtin_amdgcn_s_getreg((3 << 11) | 20) & 0xFu; }
#define XB_SPIN(cond, bar) do { unsigned _sp = 0; while (cond) { __builtin_amdgcn_s_sleep(1); \
    if ((++_sp & 255u) == 0u) { if (xb_ld(&(bar)[XB_TMO])) break; if (_sp > XB_SPIN_CAP) { atomicAdd(&(bar)[XB_TMO], 1u); break; } } } } while (0)
struct XcdBarrier { unsigned* bar; unsigned x; volatile LAS unsigned* st; };
__device__ __forceinline__ XcdBarrier xcd_barrier_post(unsigned* bar, volatile LAS unsigned* st) {
    XcdBarrier b; b.bar = bar; b.x = xb_xcc_id(); b.st = st;
    if (threadIdx.x == 0) (void)xb_add(&bar[XB_XCNT(b.x)], 1u);
    return b;
}
__device__ __forceinline__ void xcd_barrier_complete(unsigned* bar, unsigned x, unsigned& nloc, unsigned& nx) {
    const unsigned G = gridDim.x * gridDim.y * gridDim.z;
    unsigned sum, cnt, mine, sp = 0u;
    for (;;) {
        sum = 0u; cnt = 0u; mine = 0u;
#pragma unroll
        for (unsigned j = 0; j < 16; ++j) { const unsigned c = xb_ld(&bar[XB_XCNT(j)]); sum += c; cnt += (c > 0u) ? 1u : 0u; mine = (j == x) ? c : mine; }
        if (sum == G) break;
        __builtin_amdgcn_s_sleep(1);
        if ((++sp & 255u) == 0u) { if (xb_ld(&bar[XB_TMO])) break; if (sp > XB_SPIN_CAP) { atomicAdd(&bar[XB_TMO], 1u); break; } }
    }
    nloc = mine > 0u ? mine : 1u; nx = cnt > 0u ? cnt : 1u;
}
__device__ __forceinline__ void xcd_barrier(const XcdBarrier& b) {
    asm volatile("s_waitcnt vmcnt(0)" ::: "memory");
    __syncthreads();
    if (threadIdx.x == 0) {
        unsigned* bar = b.bar;
        __builtin_amdgcn_s_waitcnt(0);
        unsigned nloc = b.st[0], nx = b.st[1];
        if (nloc == 0u) { xcd_barrier_complete(bar, b.x, nloc, nx); b.st[0] = nloc; b.st[1] = nx; }
        const unsigned old = xb_add(&bar[XB_XSUB(b.x)], 1u);
        const unsigned gen = old / nloc;
        if (old + 1u == (gen + 1u) * nloc) {
            __builtin_amdgcn_fence(__ATOMIC_RELEASE, "agent");
            asm volatile("s_waitcnt vmcnt(0)" ::: "memory");
            const unsigned og = xb_add(&bar[XB_TOP], 1u);
            const unsigned tg = og / nx;
            if (og + 1u == (tg + 1u) * nx) xb_add(&bar[XB_TOPGEN], 1u);
            else XB_SPIN(xb_ld(&bar[XB_TOPGEN]) == tg, bar);
            __builtin_amdgcn_fence(__ATOMIC_ACQUIRE, "agent");
            xb_add(&bar[XB_XGEN(b.x)], 1u);
            asm volatile("s_waitcnt vmcnt(0)" ::: "memory");
        } else {
            XB_SPIN(xb_ld(&bar[XB_XGEN(b.x)]) == gen, bar);
            __builtin_amdgcn_fence(__ATOMIC_ACQUIRE, "agent");
            asm volatile("s_waitcnt vmcnt(0)" ::: "memory");
        }
    }
    __syncthreads();
}

struct Args { const float* in[27]; float* out; unsigned char* ws; int ph_lo, ph_hi; };
struct Frame {
    LAS unsigned char* lds;
    volatile LAS unsigned* MISC;
    gu32* ctl;
    int G;
    unsigned char* ws;
    float* H;
};
__device__ __forceinline__ float wave_sum(float v) {
#pragma unroll
    for (int o = 1; o < 64; o <<= 1) v += __shfl_xor(v, o);
    return v;
}
__device__ __forceinline__ float wave_max(float v) {
#pragma unroll
    for (int o = 1; o < 64; o <<= 1) v = fmaxf(v, __shfl_xor(v, o));
    return v;
}
__device__ __forceinline__ int t5_bucket(int d) {
    if (d < 16) return d;
    int b = 16;
    b += d >= 19; b += d >= 21; b += d >= 24; b += d >= 27; b += d >= 31; b += d >= 35; b += d >= 40; b += d >= 46;
    b += d >= 52; b += d >= 59; b += d >= 67; b += d >= 77; b += d >= 87; b += d >= 99; b += d >= 113;
    return b;
}
__device__ __forceinline__ void fill_blut(LAS float* blut, const float* rel_bias, int tid) {
    for (int i = tid; i < 1024; i += NWAVES * 64) { const int h = i >> 7, d = i & 127; blut[i] = rel_bias[t5_bucket(d) * 8 + h]; }
}

constexpr int TSCR = 65, TSCR_BYTES = 64 * TSCR * 4;
__device__ __forceinline__ void p0_transpose_item(const float* W, int K, int N, const float* gain, bf16* WT, int mode, LAS float* scr, int item, int lane) {
    const int nblk = N / 64, kb = item / nblk, nb = item % nblk, k0 = 64 * kb, n0 = 64 * nb;
    const int lr = lane >> 4, lc = (lane & 15) * 4;
    f32x4 v[16];
#pragma unroll
    for (int i = 0; i < 16; ++i) v[i] = *(const GAS f32x4*)(W + (size_t)(k0 + 4 * i + lr) * N + n0 + lc);
    if (gain) {
#pragma unroll
        for (int i = 0; i < 16; ++i) v[i] = v[i] * gain[k0 + 4 * i + lr]; }
#pragma unroll
    for (int i = 0; i < 16; ++i) { LAS float* d = scr + (4 * i + lr) * TSCR + lc; d[0] = v[i].x; d[1] = v[i].y; d[2] = v[i].z; d[3] = v[i].w; }
    LDS_WAIT(); asm volatile("" ::: "memory");
    const int n8 = lane & 7, c = lane >> 3;
#pragma unroll
    for (int j = 0; j < 8; ++j) { const int n = n8 + 8 * j; const LAS float* s = scr + (8 * c) * TSCR + n;
        v4u o; o.x = pk2(s[0 * TSCR], s[1 * TSCR]); o.y = pk2(s[2 * TSCR], s[3 * TSCR]); o.z = pk2(s[4 * TSCR], s[5 * TSCR]); o.w = pk2(s[6 * TSCR], s[7 * TSCR]);
        const int nn = n0 + n; const int drow = mode == 0 ? nn : (256 * (nn >> 7) + (nn & 127) + (mode == 2 ? 128 : 0));
        *(GAS v4u*)(WT + (size_t)drow * K + k0 + 8 * c) = o; }
    LDS_WAIT(); asm volatile("" ::: "memory");
}
__device__ __forceinline__ float row_to_bf16_ssq(const float* xrow, bf16* orow, int lane) {
    const GAS f32x4* xr = (const GAS f32x4*)xrow + lane;
    f32x4 v[4]; float s = 0.f;
#pragma unroll
    for (int j = 0; j < 4; ++j) { v[j] = xr[64 * j]; s += (v[j].x * v[j].x + v[j].y * v[j].y) + (v[j].z * v[j].z + v[j].w * v[j].w); }
    GAS v2u* o8 = (GAS v2u*)orow + lane;
#pragma unroll
    for (int j = 0; j < 4; ++j) { v2u w; w.x = pk2(v[j].x, v[j].y); w.y = pk2(v[j].z, v[j].w); o8[64 * j] = w; }
    return wave_sum(s);
}
__device__ __forceinline__ void cvt_f32_bf16_flat(const float* src, bf16* dst, size_t n8, int gt, int ngt) {
    for (size_t i = gt; i < n8; i += ngt) { const f32x4 a = ((const GAS f32x4*)src)[2 * i], b = ((const GAS f32x4*)src)[2 * i + 1];
        v4u o; o.x = pk2(a.x, a.y); o.y = pk2(a.z, a.w); o.z = pk2(b.x, b.y); o.w = pk2(b.z, b.w); ((GAS v4u*)dst)[i] = o; }
}
__device__ __forceinline__ void p0_prologue(Frame& F, const Args& a) {
    int tid_ = threadIdx.x; asm volatile("" : "+v"(tid_)); const int tid = tid_, lane = tid & 63, wave = __builtin_amdgcn_readfirstlane(tid >> 6); (void)lane; (void)wave;
    LAS float* scr = (LAS float*)(F.lds + wave * TSCR_BYTES);
    const int gw = blockIdx.x * NWAVES + wave, NGW = F.G * NWAVES;
    unsigned char* ws = F.ws;
    constexpr int I_WIN = 16 * 36, I_SQ = 16 * 16, I_F0 = 16 * 44, I_D0 = 44 * 16, I_PP = 4 * 16, I_QKV = 16 * 48, I_EG = 16 * 56, I_ED = 56 * 16;
    constexpr int NITEMS = I_WIN + I_SQ + 2 * I_F0 + I_D0 + I_SQ + I_PP + I_QKV + I_SQ + I_SQ + I_PP + 8 * (2 * I_EG + I_ED);
    for (int it = gw; it < NITEMS; it += NGW) {
        int r = it;
        if (r < I_WIN) { p0_transpose_item(a.in[5], D, DIN0, a.in[4], (bf16*)(ws + W_IN), 0, scr, r, lane); continue; } r -= I_WIN;
        if (r < I_SQ) { p0_transpose_item(a.in[8], D, D, nullptr, (bf16*)(ws + W_OUT), 0, scr, r, lane); continue; } r -= I_SQ;
        if (r < I_F0) { p0_transpose_item(a.in[10], D, DFF0, a.in[9], (bf16*)(ws + W_GU0), 1, scr, r, lane); continue; } r -= I_F0;
        if (r < I_F0) { p0_transpose_item(a.in[11], D, DFF0, a.in[9], (bf16*)(ws + W_GU0), 2, scr, r, lane); continue; } r -= I_F0;
        if (r < I_D0) { p0_transpose_item(a.in[12], DFF0, D, nullptr, (bf16*)(ws + W_D0), 0, scr, r, lane); continue; } r -= I_D0;
        if (r < I_SQ) { p0_transpose_item(a.in[14], D, D, a.in[13], (bf16*)(ws + W_PG0), 0, scr, r, lane); continue; } r -= I_SQ;
        if (r < I_PP) { p0_transpose_item(a.in[15], PLE, D, nullptr, (bf16*)(ws + W_PP0), 0, scr, r, lane); continue; } r -= I_PP;
        if (r < I_QKV) { p0_transpose_item(a.in[17], D, 3 * D, a.in[16], (bf16*)(ws + W_QKV), 0, scr, r, lane); continue; } r -= I_QKV;
        if (r < I_SQ) { p0_transpose_item(a.in[18], D, D, nullptr, (bf16*)(ws + W_O), 0, scr, r, lane); continue; } r -= I_SQ;
        if (r < I_SQ) { p0_transpose_item(a.in[25], D, D, a.in[24], (bf16*)(ws + W_PG1), 0, scr, r, lane); continue; } r -= I_SQ;
        if (r < I_PP) { p0_transpose_item(a.in[26], PLE, D, nullptr, (bf16*)(ws + W_PP1), 0, scr, r, lane); continue; } r -= I_PP;
        const int e = r / (2 * I_EG + I_ED); r -= e * (2 * I_EG + I_ED);
        if (r < I_EG) { p0_transpose_item(a.in[21] + (size_t)e * D * DFE, D, DFE, a.in[19], (bf16*)(ws + W_EGU) + (size_t)e * 2 * DFE * D, 1, scr, r, lane); continue; } r -= I_EG;
        if (r < I_EG) { p0_transpose_item(a.in[22] + (size_t)e * D * DFE, D, DFE, a.in[19], (bf16*)(ws + W_EGU) + (size_t)e * 2 * DFE * D, 2, scr, r, lane); continue; } r -= I_EG;
        p0_transpose_item(a.in[23] + (size_t)e * DFE * D, DFE, D, nullptr, (bf16*)(ws + W_ED) + (size_t)e * D * DFE, 0, scr, r, lane);
    }
    for (int m = gw; m < M; m += NGW) { const float s = row_to_bf16_ssq(a.in[0] + (size_t)m * D, (bf16*)(ws + WS_XBA) + (size_t)m * D, lane);
        if (lane == 0) *(GAS f32x4*)((float*)(ws + WS_SSQA) + 4 * (size_t)m) = (f32x4){s, 0.f, 0.f, 0.f}; }
    cvt_f32_bf16_flat(a.in[1], (bf16*)(ws + R_PB0), (size_t)M * PLE / 8, blockIdx.x * (NWAVES * 64) + tid, F.G * NWAVES * 64);
}

typedef short bf16x8_t __attribute__((ext_vector_type(8)));
typedef short s16x4_t __attribute__((ext_vector_type(4)));
typedef float f32x16 __attribute__((ext_vector_type(16)));
constexpr int KSTR = 272, VSTR = 320;
constexpr int KT_BYTES = 64 * KSTR, VT_BYTES = 64 * VSTR, KV_STAGE = KT_BYTES + VT_BYTES;
constexpr int ATT_LDS_KV = 8192;
constexpr int KSTR64 = 144, VSTR64 = 192;
__device__ __forceinline__ int crow16(int i, int h) { return (i & 3) + 8 * (i >> 2) + 4 * h; }
__device__ __forceinline__ int list_off(int j) { return 256 * (31 * j - (j * (j - 1)) / 2); }
__device__ __forceinline__ f32x16 mfma32(bf16x8_t a, bf16x8_t b, f32x16 c) { return __builtin_amdgcn_mfma_f32_32x32x16_bf16(a, b, c, 0, 0, 0); }
__device__ __forceinline__ s16x4_t vtr(const LAS unsigned char* p) { return __builtin_bit_cast(s16x4_t, __builtin_amdgcn_ds_read_tr16_b64_v4i16((LAS s16x4_t*)p)); }
struct KVRegs { v4u k0, k1, v0, v1; };
__device__ __forceinline__ void kv_load(KVRegs& r, const bf16* Kb, const bf16* Vb, size_t row0, int h, int tid) {
    const size_t off = (row0 + (tid >> 3)) * D + h * 128 + (tid & 7) * 8;
    r.k0 = *(const GAS v4u*)(Kb + off); r.k1 = *(const GAS v4u*)(Kb + off + 64); r.v0 = *(const GAS v4u*)(Vb + off); r.v1 = *(const GAS v4u*)(Vb + off + 64);
}
__device__ __forceinline__ void kv_store(const KVRegs& r, LAS unsigned char* stage, int tid) {
    LAS unsigned char* kp = stage + (tid >> 3) * KSTR + (tid & 7) * 16; LAS unsigned char* vp = stage + KT_BYTES + (tid >> 3) * VSTR + (tid & 7) * 16;
    *(LAS v4u*)kp = r.k0; *(LAS v4u*)(kp + 128) = r.k1; *(LAS v4u*)vp = r.v0; *(LAS v4u*)(vp + 128) = r.v1;
}
template <int NKS, int KS_> __device__ __forceinline__ void attn_qk(const LAS unsigned char* Kt, const bf16x8_t (&qf)[NKS], f32x16& p0, f32x16& p1, int lane) {
    const LAS unsigned char* kb = Kt + (lane & 31) * KS_ + (lane >> 5) * 16;
#pragma unroll
    for (int ks = 0; ks < NKS; ++ks) { const bf16x8_t a0 = *(const LAS bf16x8_t*)(kb + ks * 32), a1 = *(const LAS bf16x8_t*)(kb + 32 * KS_ + ks * 32);
        if (ks == 0) { f32x16 z; for (int i = 0; i < 16; ++i) z[i] = 0.f; p0 = mfma32(a0, qf[0], z); p1 = mfma32(a1, qf[0], z); }
        else { p0 = mfma32(a0, qf[ks], p0); p1 = mfma32(a1, qf[ks], p1); } }
}
template <int NDT, int VS_> __device__ __forceinline__ void attn_softmax_pv(const LAS unsigned char* Vt, f32x16& p0, f32x16& p1, f32x16 (&o)[NDT], float& m, float& l, int lane) {
    float mt = p0[0];
#pragma unroll
    for (int i = 1; i < 16; ++i) mt = fmaxf(mt, p0[i]);
#pragma unroll
    for (int i = 0; i < 16; ++i) mt = fmaxf(mt, p1[i]);
    mt = fmaxf(mt, __shfl_xor(mt, 32));
    const float mn = fmaxf(m, mt); const float ms = mn == -INFINITY ? 0.f : mn;
    const float alpha = __builtin_amdgcn_exp2f(m - ms);
    float ls = 0.f;
#pragma unroll
    for (int i = 0; i < 16; ++i) { p0[i] = __builtin_amdgcn_exp2f(p0[i] - ms); ls += p0[i]; }
#pragma unroll
    for (int i = 0; i < 16; ++i) { p1[i] = __builtin_amdgcn_exp2f(p1[i] - ms); ls += p1[i]; }
    l = l * alpha + ls; m = mn;
#pragma unroll
    for (int dt = 0; dt < NDT; ++dt)
#pragma unroll
        for (int i = 0; i < 16; ++i) o[dt][i] *= alpha;
    bf16x8_t pb[4];
#pragma unroll
    for (int s = 0; s < 4; ++s) { v4u w;
        if (s < 2) { w.x = pk2(p0[8 * s + 0], p0[8 * s + 1]); w.y = pk2(p0[8 * s + 2], p0[8 * s + 3]); w.z = pk2(p0[8 * s + 4], p0[8 * s + 5]); w.w = pk2(p0[8 * s + 6], p0[8 * s + 7]); }
        else { const int t = s - 2; w.x = pk2(p1[8 * t + 0], p1[8 * t + 1]); w.y = pk2(p1[8 * t + 2], p1[8 * t + 3]); w.z = pk2(p1[8 * t + 4], p1[8 * t + 5]); w.w = pk2(p1[8 * t + 6], p1[8 * t + 7]); }
        pb[s] = __builtin_bit_cast(bf16x8_t, w); }
    const int i16 = lane & 15, q4 = i16 >> 2, p4 = i16 & 3, blk = (lane >> 4) & 1, hh = lane >> 5;
    const LAS unsigned char* vb = Vt + (4 * hh + q4) * VS_ + blk * 32 + p4 * 8;
#pragma unroll
    for (int dt = 0; dt < NDT; ++dt)
#pragma unroll
        for (int s = 0; s < 4; ++s) { const s16x4_t lo = vtr(vb + (16 * s) * VS_ + dt * 64), hi = vtr(vb + (16 * s + 8) * VS_ + dt * 64);
            const bf16x8_t vf = __builtin_shufflevector(lo, hi, 0, 1, 2, 3, 4, 5, 6, 7);
            o[dt] = mfma32(vf, pb[s], o[dt]); }
}

__device__ __forceinline__ void l0_mixer_naive(Frame& F, const Args& a) {
    int tid_ = threadIdx.x; asm volatile("" : "+v"(tid_)); const int tid = tid_, lane = tid & 63, wave = __builtin_amdgcn_readfirstlane(tid >> 6); (void)lane; (void)wave;
    const bf16* Z = (const bf16*)(F.ws + R_Z); bf16* MIX = (bf16*)(F.ws + R_MIX);
    const int gw = blockIdx.x * NWAVES + wave, NGW = F.G * NWAVES;
    {
        const float* cw = a.in[6];
        const int c0 = lane * 8;
        float w0[8], w1[8], w2[8];
#pragma unroll
        for (int j = 0; j < 8; ++j) { w0[j] = cw[c0 + j]; w1[j] = cw[512 + c0 + j]; w2[j] = cw[1024 + c0 + j]; }
        for (int tok = gw; tok < M; tok += NGW) {
            const int t = tok & (SEQ - 1);
            float acc[8];
#pragma unroll
            for (int j = 0; j < 8; ++j) acc[j] = 0.f;
#pragma unroll
            for (int dt = 0; dt < 3; ++dt) {
                if (t - dt >= 0) {
                    const bf16* zr = Z + (size_t)(tok - dt) * DIN0;
                    const v4u cc = *(const GAS v4u*)(zr + ZC_C + c0), uu = *(const GAS v4u*)(zr + ZC_U + c0);
                    const unsigned cw4[4] = {cc.x, cc.y, cc.z, cc.w}, uw4[4] = {uu.x, uu.y, uu.z, uu.w};
#pragma unroll
                    for (int q = 0; q < 4; ++q) { const float p0 = bflo(cw4[q]) * bflo(uw4[q]), p1 = bfhi(cw4[q]) * bfhi(uw4[q]);
                        const float wa = dt == 0 ? w2[2 * q] : (dt == 1 ? w1[2 * q] : w0[2 * q]), wb = dt == 0 ? w2[2 * q + 1] : (dt == 1 ? w1[2 * q + 1] : w0[2 * q + 1]);
                        acc[2 * q] += wa * p0; acc[2 * q + 1] += wb * p1; }
                }
            }
            const v4u bb = *(const GAS v4u*)(Z + (size_t)tok * DIN0 + ZC_B + c0);
            v4u o; o.x = pk2(bflo(bb.x) * acc[0], bfhi(bb.x) * acc[1]); o.y = pk2(bflo(bb.y) * acc[2], bfhi(bb.y) * acc[3]);
            o.z = pk2(bflo(bb.z) * acc[4], bfhi(bb.z) * acc[5]); o.w = pk2(bflo(bb.w) * acc[6], bfhi(bb.w) * acc[7]);
            *(GAS v4u*)(MIX + (size_t)tok * D + c0) = o;
        }
    }
    LAS float* blut = (LAS float*)F.lds;
    __syncthreads();
    for (int i = tid; i < 1024; i += NWAVES * 64) { const int hd = i >> 7, d = i & 127; blut[i] = a.in[2][t5_bucket(d) * 8 + hd] * LOG2E; }
    LAS unsigned char* Kl = F.lds + 4096; LAS unsigned char* Vl = Kl + 256 * KSTR64;
    const int r32 = lane & 31, hh = lane >> 5;
    for (int u = blockIdx.x; u < 2 * 2 * 64; u += F.G) {
        const int qb = u & 63, kvh = (u >> 6) & 1, b = u >> 7;
        __syncthreads();
#pragma unroll
        for (int i = 0; i < 4; ++i) { const int c = tid + 512 * i, row = c >> 3, c16 = c & 7; int pos = 128 * (qb - 1) + row; pos = pos < 0 ? 0 : pos;
            const bf16* zr = Z + (size_t)(b * SEQ + pos) * DIN0 + kvh * 64 + c16 * 8;
            *(LAS v4u*)(Kl + row * KSTR64 + c16 * 16) = *(const GAS v4u*)(zr + ZC_K); *(LAS v4u*)(Vl + row * VSTR64 + c16 * 16) = *(const GAS v4u*)(zr + ZC_V); }
        __syncthreads();
        const int g = wave >> 1, qh = wave & 1, hd = kvh * 4 + g;
        const float sinkl = a.in[7][hd] * LOG2E;
#pragma unroll 1
        for (int sub = 0; sub < 2; ++sub) {
            const int qrel = 64 * qh + 32 * sub + r32;
            const int tok = b * SEQ + 128 * qb + qrel;
            bf16x8_t qf[4];
            { const GAS bf16x8_t* qp = (const GAS bf16x8_t*)(Z + (size_t)tok * DIN0 + ZC_Q + hd * 64 + 8 * hh);
#pragma unroll
              for (int ks = 0; ks < 4; ++ks) qf[ks] = qp[2 * ks]; }
            f32x16 o[2];
#pragma unroll
            for (int dt = 0; dt < 2; ++dt)
#pragma unroll
                for (int i = 0; i < 16; ++i) o[dt][i] = 0.f;
            float m = -INFINITY, l = 0.f;
#pragma unroll 1
            for (int kk = 0; kk < 3; ++kk) {
                const int kt = qh + kk;
                if (qb == 0 && kt < 2) continue;
                f32x16 p0, p1;
                attn_qk<4, KSTR64>(Kl + kt * 64 * KSTR64, qf, p0, p1, lane);
#pragma unroll
                for (int i = 0; i < 16; ++i) { const int d0 = (128 + qrel) - (kt * 64 + crow16(i, hh)), d1 = d0 - 32;
                    p0[i] = (d0 >= 0 && d0 < 128) ? p0[i] + blut[hd * 128 + d0] : -INFINITY;
                    p1[i] = (d1 >= 0 && d1 < 128) ? p1[i] + blut[hd * 128 + d1] : -INFINITY; }
                attn_softmax_pv<2, VSTR64>(Vl + kt * 64 * VSTR64, p0, p1, o, m, l, lane);
            }
            l += __shfl_xor(l, 32);
            const float inv = 1.0f / (l + __builtin_amdgcn_exp2f(sinkl - m));
            bf16* mo = MIX + (size_t)tok * D + 512 + hd * 64 + 4 * hh;
#pragma unroll
            for (int dt = 0; dt < 2; ++dt)
#pragma unroll
                for (int gg = 0; gg < 4; ++gg) { v2u w; w.x = pk2(o[dt][4 * gg] * inv, o[dt][4 * gg + 1] * inv); w.y = pk2(o[dt][4 * gg + 2] * inv, o[dt][4 * gg + 3] * inv); *(GAS v2u*)(mo + 32 * dt + 8 * gg) = w; }
        }
    }
}

__device__ __forceinline__ void l1_kmean(Frame& F) {
    int tid_ = threadIdx.x; asm volatile("" : "+v"(tid_)); const int tid = tid_, lane = tid & 63, wave = __builtin_amdgcn_readfirstlane(tid >> 6); (void)lane; (void)wave;
    const bf16* Kb = (const bf16*)(F.ws + R_K); float* KM = (float*)(F.ws + WS_KM);
    LAS float* red = (LAS float*)F.lds;
    for (int task = blockIdx.x; task < 2 * 32 * 8; task += F.G) {
        const int h = task & 7, bn = task >> 3;
        const bf16* base = Kb + (size_t)(bn * 256 + wave * 32) * D + h * 128 + 2 * lane;
        float s0 = 0.f, s1 = 0.f;
        for (int r = 0; r < 32; ++r) { const unsigned w = *(const GAS unsigned*)(base + (size_t)r * D); s0 += bflo(w); s1 += bfhi(w); }
        red[wave * 128 + 2 * lane] = s0; red[wave * 128 + 2 * lane + 1] = s1;
        __syncthreads();
        if (tid < 128) { float s = 0.f;
#pragma unroll
            for (int w = 0; w < 8; ++w) s += red[w * 128 + tid];
            KM[(size_t)bn * D + h * 128 + tid] = s * (1.0f / 256.0f); }
        __syncthreads();
    }
}
__device__ __forceinline__ void l1_moba_select(Frame& F) {
    int tid_ = threadIdx.x; asm volatile("" : "+v"(tid_)); const int tid = tid_, lane = tid & 63, wave = __builtin_amdgcn_readfirstlane(tid >> 6); (void)lane; (void)wave;
    const bf16* Qb = (const bf16*)(F.ws + R_Q); const float* KM = (const float*)(F.ws + WS_KM);
    unsigned* lcnt = (unsigned*)(F.ctl + CW_LCNT); int* lists = (int*)(F.ws + R_LIST);
    LAS float* kmL = (LAS float*)F.lds;
    for (int chunk = blockIdx.x; chunk < 256; chunk += F.G) {
        const int bh = chunk >> 4, g = chunk & 15, b = bh >> 3, h = bh & 7;
        __syncthreads();
        for (int i = tid; i < 4096; i += NWAVES * 64) kmL[i] = KM[(size_t)(b * 32 + (i >> 7)) * D + h * 128 + (i & 127)];
        __syncthreads();
        const int t = g * 512 + wave * 64 + lane, qblk = (g * 512 + wave * 64) >> 8;
        if (qblk == 0) continue;
        float acc[31];
#pragma unroll
        for (int n = 0; n < 31; ++n) acc[n] = 0.f;
        const GAS v4u* qr = (const GAS v4u*)(Qb + (size_t)(b * SEQ + t) * D + h * 128);
#pragma unroll 1
        for (int c = 0; c < 16; ++c) { const v4u w = qr[c];
            const float q0 = bflo(w.x), q1 = bfhi(w.x), q2 = bflo(w.y), q3 = bfhi(w.y), q4 = bflo(w.z), q5 = bfhi(w.z), q6 = bflo(w.w), q7 = bfhi(w.w);
#pragma unroll
            for (int n = 0; n < 31; ++n) if (n < qblk) { const f32x4 ka = *(const LAS f32x4*)(kmL + n * 128 + c * 8), kb = *(const LAS f32x4*)(kmL + n * 128 + c * 8 + 4);
                acc[n] += (q0 * ka.x + q1 * ka.y) + (q2 * ka.z + q3 * ka.w) + (q4 * kb.x + q5 * kb.y) + (q6 * kb.z + q7 * kb.w); } }
        float v1 = -INFINITY, v2 = -INFINITY, v3 = -INFINITY; int i1 = -1, i2 = -1, i3 = -1;
#pragma unroll
        for (int n = 0; n < 31; ++n) if (n < qblk) { const float v = acc[n];
            if (v > v1) { v3 = v2; i3 = i2; v2 = v1; i2 = i1; v1 = v; i1 = n; } else if (v > v2) { v3 = v2; i3 = i2; v2 = v; i2 = n; } else if (v > v3) { v3 = v; i3 = n; } }
        for (int j = 0; j < qblk; ++j) {
            const bool hit = (i1 == j) | (i2 == j) | (i3 == j);
            const unsigned long long mk = __ballot(hit);
            if (mk == 0ull) continue;
            const int cntj = __popcll(mk);
            unsigned base = 0;
            if (lane == 0) base = __hip_atomic_fetch_add(lcnt + bh * 32 + j, (unsigned)cntj, __ATOMIC_RELAXED, __HIP_MEMORY_SCOPE_AGENT);
            base = __builtin_amdgcn_readfirstlane(base);
            if (hit) { const int off = __popcll(mk & ((1ull << lane) - 1ull)); const int rk = (i1 == j) ? 0 : ((i2 == j) ? 1 : 2);
                const unsigned idx = base + off;
                if (idx < (unsigned)(256 * (31 - j))) lists[(size_t)bh * 126976 + list_off(j) + idx] = t | (rk << 13); }
        }
    }
}
__device__ __forceinline__ void l1_moba_partial(Frame& F, const Args& a) {
    int tid_ = threadIdx.x; asm volatile("" : "+v"(tid_)); const int tid = tid_, lane = tid & 63, wave = __builtin_amdgcn_readfirstlane(tid >> 6); (void)lane; (void)wave;
    const bf16* Qb = (const bf16*)(F.ws + R_Q); const bf16* Kb = (const bf16*)(F.ws + R_K); const bf16* Vb = (const bf16*)(F.ws + R_V);
    bf16* PO = (bf16*)(F.ws + R_PO); float* ML = (float*)(F.ws + R_ML);
    const unsigned* lcnt = (const unsigned*)(F.ctl + CW_LCNT); const int* lists = (const int*)(F.ws + R_LIST);
    const int r32 = lane & 31, hh = lane >> 5;
    LAS float* blut = (LAS float*)F.lds; LAS int* pre = (LAS int*)(F.lds + 4096);
    for (int i = tid; i < 1024; i += NWAVES * 64) { const int hd = i >> 7, d = i & 127; blut[i] = (a.in[2][t5_bucket(d) * 8 + hd] - a.in[2][31 * 8 + hd]) * LOG2E; }
    {
        const int li = tid; const int jj = li & 31; unsigned c = lcnt[li]; const unsigned cap = 256u * (31 - jj); c = c > cap ? cap : c;
        const int tiles = (int)((c + 255u) >> 8);
        int x = tiles;
#pragma unroll
        for (int o = 1; o < 64; o <<= 1) { const int y = __shfl_up(x, o); if (lane >= o) x += y; }
        LAS int* wt = pre + 520;
        if (lane == 63) wt[wave] = x;
        __syncthreads();
        int wo = 0;
#pragma unroll
        for (int w = 0; w < 8; ++w) if (w < wave) wo += wt[w];
        pre[li + 1] = wo + x; if (li == 0) pre[0] = 0;
        __syncthreads();
    }
    const int total = pre[512];
    LAS unsigned char* kv = F.lds + ATT_LDS_KV;
    for (int u = blockIdx.x; u < total; u += F.G) {
        int lo = 0, hi = 511;
        while (lo < hi) { const int mid = (lo + hi + 1) >> 1; if (pre[mid] <= u) lo = mid; else hi = mid - 1; }
        const int li = lo, tile = u - pre[li], bh = li >> 5, j = li & 31, b = bh >> 3, h = bh & 7;
        unsigned nl = lcnt[li]; { const unsigned cap = 256u * (31 - j); nl = nl > cap ? cap : nl; }
        const int ridx = tile * 256 + wave * 32 + r32; const bool rvalid = ridx < (int)nl;
        const int ent = lists[(size_t)bh * 126976 + list_off(j) + (rvalid ? ridx : 0)];
        const int t = ent & 8191, rk = ent >> 13;
        bf16x8_t qf[8];
        { const GAS bf16x8_t* qp = (const GAS bf16x8_t*)(Qb + (size_t)(b * SEQ + t) * D + h * 128 + 8 * hh);
#pragma unroll
          for (int ks = 0; ks < 8; ++ks) qf[ks] = qp[2 * ks]; }
        const bool near = t < j * 256 + 382;
        const bool anynear = __any(near);
        f32x16 o[4];
#pragma unroll
        for (int dt = 0; dt < 4; ++dt)
#pragma unroll
            for (int i = 0; i < 16; ++i) o[dt][i] = 0.f;
        float m = -INFINITY, l = 0.f;
        const size_t krow0 = (size_t)b * SEQ + j * 256;
        KVRegs kr;
        __syncthreads();
        kv_load(kr, Kb, Vb, krow0, h, tid); kv_store(kr, kv, tid);
        __syncthreads();
#pragma unroll 1
        for (int kt = 0; kt < 4; ++kt) {
            if (kt < 3) kv_load(kr, Kb, Vb, krow0 + (kt + 1) * 64, h, tid);
            const LAS unsigned char* st = kv + (kt & 1) * KV_STAGE;
            f32x16 p0, p1;
            attn_qk<8, KSTR>(st, qf, p0, p1, lane);
            if (anynear && kt >= 2) { const int kp0 = j * 256 + kt * 64;
#pragma unroll
                for (int i = 0; i < 16; ++i) { int d0 = t - (kp0 + crow16(i, hh)); int d1 = d0 - 32; d0 = d0 > 127 ? 127 : d0; d1 = d1 > 127 ? 127 : d1;
                    p0[i] += blut[h * 128 + d0]; p1[i] += blut[h * 128 + d1]; } }
            attn_softmax_pv<4, VSTR>(st + KT_BYTES, p0, p1, o, m, l, lane);
            if (kt < 3) kv_store(kr, kv + ((kt + 1) & 1) * KV_STAGE, tid);
            __syncthreads();
        }
        l += __shfl_xor(l, 32);
        if (rvalid) {
            const size_t pidx = ((size_t)((rk * 2 + b) * 8 + h) * SEQ + t);
            if (hh == 0) *(GAS pg8::f32x2*)(ML + pidx * 2) = (pg8::f32x2){m, l};
            bf16* po = PO + pidx * 128 + 4 * hh;
#pragma unroll
            for (int dt = 0; dt < 4; ++dt)
#pragma unroll
                for (int g = 0; g < 4; ++g) { v2u w; w.x = pk2(o[dt][4 * g], o[dt][4 * g + 1]); w.y = pk2(o[dt][4 * g + 2], o[dt][4 * g + 3]); *(GAS v2u*)(po + 32 * dt + 8 * g) = w; }
        }
    }
}
__device__ __forceinline__ void l1_moba_own_merge(Frame& F, const Args& a) {
    int tid_ = threadIdx.x; asm volatile("" : "+v"(tid_)); const int tid = tid_, lane = tid & 63, wave = __builtin_amdgcn_readfirstlane(tid >> 6); (void)lane; (void)wave;
    const bf16* Qb = (const bf16*)(F.ws + R_Q); const bf16* Kb = (const bf16*)(F.ws + R_K); const bf16* Vb = (const bf16*)(F.ws + R_V);
    const bf16* PO = (const bf16*)(F.ws + R_PO); const float* ML = (const float*)(F.ws + R_ML); bf16* ATT = (bf16*)(F.ws + R_ATT);
    const int r32 = lane & 31, hh = lane >> 5;
    LAS float* blut = (LAS float*)F.lds;
    __syncthreads();
    for (int i = tid; i < 1024; i += NWAVES * 64) { const int hd = i >> 7, d = i & 127; blut[i] = a.in[2][t5_bucket(d) * 8 + hd] * LOG2E; }
    __syncthreads();
    LAS unsigned char* kv = F.lds + ATT_LDS_KV;
    for (int u = blockIdx.x; u < 512; u += F.G) {
        const int bh = u >> 5, ib = u & 31, b = bh >> 3, h = bh & 7;
        const int qrel = wave * 32 + r32, t = ib * 256 + qrel;
        bf16x8_t qf[8];
        { const GAS bf16x8_t* qp = (const GAS bf16x8_t*)(Qb + (size_t)(b * SEQ + t) * D + h * 128 + 8 * hh);
#pragma unroll
          for (int ks = 0; ks < 8; ++ks) qf[ks] = qp[2 * ks]; }
        f32x16 o[4];
#pragma unroll
        for (int dt = 0; dt < 4; ++dt)
#pragma unroll
            for (int i = 0; i < 16; ++i) o[dt][i] = 0.f;
        float m = -INFINITY, l = 0.f;
        const size_t krow0 = (size_t)b * SEQ + ib * 256;
        KVRegs kr;
        __syncthreads();
        kv_load(kr, Kb, Vb, krow0, h, tid); kv_store(kr, kv, tid);
        __syncthreads();
#pragma unroll 1
        for (int kt = 0; kt < 4; ++kt) {
            if (kt < 3) kv_load(kr, Kb, Vb, krow0 + (kt + 1) * 64, h, tid);
            const LAS unsigned char* st = kv + (kt & 1) * KV_STAGE;
            if (kt * 64 <= wave * 32 + 31) {
                f32x16 p0, p1;
                attn_qk<8, KSTR>(st, qf, p0, p1, lane);
#pragma unroll
                for (int i = 0; i < 16; ++i) { const int d0 = qrel - (kt * 64 + crow16(i, hh)), d1 = d0 - 32;
                    p0[i] = d0 >= 0 ? p0[i] + blut[h * 128 + (d0 > 127 ? 127 : d0)] : -INFINITY;
                    p1[i] = d1 >= 0 ? p1[i] + blut[h * 128 + (d1 > 127 ? 127 : d1)] : -INFINITY; }
                attn_softmax_pv<4, VSTR>(st + KT_BYTES, p0, p1, o, m, l, lane);
            }
            if (kt < 3) kv_store(kr, kv + ((kt + 1) & 1) * KV_STAGE, tid);
            __syncthreads();
        }
        l += __shfl_xor(l, 32);
        const int nsel = ib < 3 ? ib : 3;
        const float c31 = blut[h * 128 + 127];
        float mr[3], lr[3]; float mx = m;
#pragma unroll
        for (int r = 0; r < 3; ++r) { mr[r] = -INFINITY; lr[r] = 0.f;
            if (r < nsel) { const size_t pidx = ((size_t)((r * 2 + b) * 8 + h) * SEQ + t); const pg8::f32x2 v = *(const GAS pg8::f32x2*)(ML + pidx * 2); mr[r] = v[0] + c31; lr[r] = v[1]; mx = fmaxf(mx, mr[r]); } }
        const float f0 = __builtin_amdgcn_exp2f(m - mx);
        float lt = l * f0;
#pragma unroll
        for (int dt = 0; dt < 4; ++dt)
#pragma unroll
            for (int i = 0; i < 16; ++i) o[dt][i] *= f0;
#pragma unroll
        for (int r = 0; r < 3; ++r) if (r < nsel) { const float fr = __builtin_amdgcn_exp2f(mr[r] - mx); lt += lr[r] * fr;
            const bf16* po = PO + ((size_t)((r * 2 + b) * 8 + h) * SEQ + t) * 128 + 4 * hh;
#pragma unroll
            for (int dt = 0; dt < 4; ++dt)
#pragma unroll
                for (int g = 0; g < 4; ++g) { const v2u w = *(const GAS v2u*)(po + 32 * dt + 8 * g);
                    o[dt][4 * g] += fr * bflo(w.x); o[dt][4 * g + 1] += fr * bfhi(w.x); o[dt][4 * g + 2] += fr * bflo(w.y); o[dt][4 * g + 3] += fr * bfhi(w.y); } }
        const float inv = 1.0f / lt;
        bf16* ao = ATT + (size_t)(b * SEQ + t) * D + h * 128 + 4 * hh;
#pragma unroll
        for (int dt = 0; dt < 4; ++dt)
#pragma unroll
            for (int g = 0; g < 4; ++g) { v2u w; w.x = pk2(o[dt][4 * g] * inv, o[dt][4 * g + 1] * inv); w.y = pk2(o[dt][4 * g + 2] * inv, o[dt][4 * g + 3] * inv); *(GAS v2u*)(ao + 32 * dt + 8 * g) = w; }
    }
}

__device__ __forceinline__ void l1_route(Frame& F, const Args& a) {
    int tid_ = threadIdx.x; asm volatile("" : "+v"(tid_)); const int tid = tid_, lane = tid & 63, wave = __builtin_amdgcn_readfirstlane(tid >> 6); (void)lane; (void)wave;
    LAS float* WrL = (LAS float*)F.lds;
    LAS int* lcnt = (LAS int*)(F.lds + 32768);
    LAS int* lbase = lcnt + 8;
    LAS int* tiE = lcnt + 16;
    LAS int* tiL = tiE + 128;
    LAS float* tiW = (LAS float*)(tiL + 128);
    LAS float* tiR = tiW + 128;
    const float* router = a.in[20]; const float* gain = a.in[19];
    for (int i = tid; i < 8192; i += NWAVES * 64) WrL[i] = router[i] * gain[i >> 3];
    unsigned* gcnt = (unsigned*)(F.ctl + CW_ECNT);
    int* tok_e = (int*)(F.ws + WS_TOKE); float* gw_e = (float*)(F.ws + WS_GWE); float* rs_e = (float*)(F.ws + WS_RSE); int* pos = (int*)(F.ws + WS_POS);
    for (int chunk = blockIdx.x; chunk < M / 64; chunk += F.G) {
        if (tid < 8) lcnt[tid] = 0;
        __syncthreads();
        for (int tt = wave; tt < 64; tt += NWAVES) {
            const int tok = chunk * 64 + tt;
            const GAS f32x4* hr = (const GAS f32x4*)(F.H + (size_t)tok * D) + lane;
            float lg[8]; float ss = 0.f;
#pragma unroll
            for (int e = 0; e < 8; ++e) lg[e] = 0.f;
#pragma unroll
            for (int j = 0; j < 4; ++j) { const f32x4 hv = hr[64 * j]; const float hx[4] = {hv.x, hv.y, hv.z, hv.w};
#pragma unroll
                for (int q = 0; q < 4; ++q) { const int k = j * 256 + lane * 4 + q; const f32x4 wa = *(const LAS f32x4*)(WrL + k * 8), wb = *(const LAS f32x4*)(WrL + k * 8 + 4);
                    ss += hx[q] * hx[q];
                    lg[0] += hx[q] * wa.x; lg[1] += hx[q] * wa.y; lg[2] += hx[q] * wa.z; lg[3] += hx[q] * wa.w; lg[4] += hx[q] * wb.x; lg[5] += hx[q] * wb.y; lg[6] += hx[q] * wb.z; lg[7] += hx[q] * wb.w; } }
            ss = wave_sum(ss);
#pragma unroll
            for (int e = 0; e < 8; ++e) lg[e] = wave_sum(lg[e]);
            const float rs = rsqrtf(ss * (1.0f / 1024.0f) + EPS);
            float v0 = lg[0]; int e0 = 0;
#pragma unroll
            for (int e = 1; e < 8; ++e) if (lg[e] > v0) { v0 = lg[e]; e0 = e; }
            float v1 = -INFINITY; int e1 = 0;
#pragma unroll
            for (int e = 0; e < 8; ++e) if (e != e0 && lg[e] > v1) { v1 = lg[e]; e1 = e; }
            const float w0 = 1.0f / (1.0f + __expf((v1 - v0) * rs)), w1 = 1.0f - w0;
            if (lane == 0) { const int l0 = __hip_atomic_fetch_add(&lcnt[e0], 1, __ATOMIC_RELAXED, __HIP_MEMORY_SCOPE_WORKGROUP), l1 = __hip_atomic_fetch_add(&lcnt[e1], 1, __ATOMIC_RELAXED, __HIP_MEMORY_SCOPE_WORKGROUP);
                tiE[2 * tt] = e0; tiE[2 * tt + 1] = e1; tiL[2 * tt] = l0; tiL[2 * tt + 1] = l1; tiW[2 * tt] = w0; tiW[2 * tt + 1] = w1; tiR[tt] = rs; }
        }
        __syncthreads();
        if (tid < 8) lbase[tid] = (int)__hip_atomic_fetch_add(gcnt + tid, (unsigned)lcnt[tid], __ATOMIC_RELAXED, __HIP_MEMORY_SCOPE_AGENT);
        __syncthreads();
        if (tid < 128) { const int tt = tid >> 1, e = tiE[tid], idx = lbase[e] + tiL[tid], tok = chunk * 64 + tt;
            if (idx < 16384) { tok_e[e * 16384 + idx] = tok; gw_e[e * 16384 + idx] = tiW[tid]; rs_e[e * 16384 + idx] = tiR[tt]; }
            pos[2 * tok + (tid & 1)] = (e << 16) | idx; }
        __syncthreads();
    }
}
__device__ __forceinline__ void l1_combine(Frame& F, const Args& a) {
    int tid_ = threadIdx.x; asm volatile("" : "+v"(tid_)); const int tid = tid_, lane = tid & 63, wave = __builtin_amdgcn_readfirstlane(tid >> 6); (void)lane; (void)wave;
    const int gw = blockIdx.x * NWAVES + wave, NGW = F.G * NWAVES;
    const int* cntp = (const int*)(F.ctl + CW_ECNT); const int* pos = (const int*)(F.ws + WS_POS);
    pg8::MoeTiles T; T.init(cntp);
    int main_tiles; { int nl = T.t8 - 128; nl = nl < 0 ? 0 : (nl > MOE_SUB_TILES ? MOE_SUB_TILES : nl); main_tiles = T.t8 - nl; }
    const float* YP = (const float*)(F.ws + R_YP);
    const bf16* Y = (const bf16*)(F.ws + R_Y); bf16* XB = (bf16*)(F.ws + WS_XBA); float* ssq = (float*)(F.ws + WS_SSQA);
    for (int tok = gw; tok < M; tok += NGW) {
        const int p0 = pos[2 * tok], p1 = pos[2 * tok + 1];
        const int b0 = T.base_of(p0 >> 16), b1 = T.base_of(p1 >> 16);
        const size_t r0 = (size_t)b0 * 256 + (p0 & 0xffff), r1 = (size_t)b1 * 256 + (p1 & 0xffff);
        const bool sub0 = (int)(r0 >> 8) >= main_tiles, sub1 = (int)(r1 >> 8) >= main_tiles;
        GAS f32x4* hr = (GAS f32x4*)(F.H + (size_t)tok * D) + lane;
        const GAS v2u* y0 = (const GAS v2u*)(Y + r0 * D) + lane; const GAS v2u* y1 = (const GAS v2u*)(Y + r1 * D) + lane;
        GAS v2u* xo = (GAS v2u*)(XB + (size_t)tok * D) + lane;
        float s = 0.f;
#pragma unroll
        for (int j = 0; j < 4; ++j) { f32x4 h = hr[64 * j];
            f32x4 ya, yb;
            if (sub0) { ya = (f32x4){0.f, 0.f, 0.f, 0.f}; const GAS f32x4* yp = (const GAS f32x4*)(YP + (r0 - (size_t)main_tiles * 256) * D) + lane + 64 * j;
#pragma unroll
                for (int kc = 0; kc < MOE_NKC; ++kc) ya = ya + yp[(size_t)kc * MOE_SUB_TILES * 256 * D / 4]; }
            else { const v2u a0 = y0[64 * j]; ya = (f32x4){bflo(a0.x), bfhi(a0.x), bflo(a0.y), bfhi(a0.y)}; }
            if (sub1) { yb = (f32x4){0.f, 0.f, 0.f, 0.f}; const GAS f32x4* yp = (const GAS f32x4*)(YP + (r1 - (size_t)main_tiles * 256) * D) + lane + 64 * j;
#pragma unroll
                for (int kc = 0; kc < MOE_NKC; ++kc) yb = yb + yp[(size_t)kc * MOE_SUB_TILES * 256 * D / 4]; }
            else { const v2u a1 = y1[64 * j]; yb = (f32x4){bflo(a1.x), bfhi(a1.x), bflo(a1.y), bfhi(a1.y)}; }
            h = h + ya + yb;
            hr[64 * j] = h; v2u w; w.x = pk2(h.x, h.y); w.y = pk2(h.z, h.w); xo[64 * j] = w;
            s += (h.x * h.x + h.y * h.y) + (h.z * h.z + h.w * h.w); }
        s = wave_sum(s);
        if (lane == 0) *(GAS f32x4*)(ssq + 4 * (size_t)tok) = (f32x4){s, 0.f, 0.f, 0.f};
    }
    cvt_f32_bf16_flat(a.in[1] + (size_t)M * PLE, (bf16*)(F.ws + R_PB1), (size_t)M * PLE / 8, blockIdx.x * (NWAVES * 64) + tid, F.G * NWAVES * 64);
}
__device__ __forceinline__ void final_norm(Frame& F, const Args& a) {
    int tid_ = threadIdx.x; asm volatile("" : "+v"(tid_)); const int tid = tid_, lane = tid & 63, wave = __builtin_amdgcn_readfirstlane(tid >> 6); (void)lane; (void)wave;
    const int gw = blockIdx.x * NWAVES + wave, NGW = F.G * NWAVES;
    const float* ssq = (const float*)(F.ws + WS_SSQB); const float* g = a.in[3];
    f32x4 gv[4];
#pragma unroll
    for (int j = 0; j < 4; ++j) gv[j] = ((const GAS f32x4*)g)[64 * j + lane];
    for (int tok = gw; tok < M; tok += NGW) {
        const float rs = pg8::rstd_of(ssq, tok);
        GAS f32x4* hr = (GAS f32x4*)(F.H + (size_t)tok * D) + lane;
#pragma unroll
        for (int j = 0; j < 4; ++j) { f32x4 h = hr[64 * j]; h = h * rs * gv[j]; hr[64 * j] = h; }
    }
}

constexpr int N_PHASES = 19;
__global__ void __launch_bounds__(NWAVES * 64, 2) trunk_fwd(Args args) {
    extern __shared__ __attribute__((aligned(16))) unsigned char lds[];
    Frame F;
    F.lds = (LAS unsigned char*)lds;
    F.MISC = (volatile LAS unsigned*)(F.lds + MISC_OFF);
    F.G = gridDim.x;
    F.ws = args.ws; F.ctl = (gu32*)(args.ws + WS_CTL); F.H = args.out;
    unsigned char* ws = args.ws;
    for (int u = threadIdx.x; u < (LDS_BYTES - LDSCTL_OFF) / 4; u += NWAVES * 64) ((LAS unsigned*)(F.lds + LDSCTL_OFF))[u] = 0u;
    __syncthreads();
    XcdBarrier bar; bar.bar = (unsigned*)(F.ctl + CW_BAR); bar.x = 0; bar.st = nullptr;
    const int lo = args.ph_lo, hi = args.ph_hi;
    if (hi - lo > 1) bar = xcd_barrier_post((unsigned*)(F.ctl + CW_BAR), F.MISC + 8);
#define IN(k) (lo <= (k) && (k) < hi)
#define SEAM(k) do { if (IN(k) && IN((k) + 1)) xcd_barrier(bar); } while (0)
    const int bx = (int)blockIdx.x;
    float* SSQA = (float*)(ws + WS_SSQA); float* SSQB = (float*)(ws + WS_SSQB);
    bf16* XBA = (bf16*)(ws + WS_XBA); bf16* XBB = (bf16*)(ws + R_XBB);

    if (IN(0)) { p0_prologue(F, args); } SEAM(0);
    if (IN(1)) { pg8::Gemm g{XBA, (const bf16*)(ws + W_IN), D, 0, D}; pg8::StaticOrder S; S.init(M, DIN0, F.G, bx);
        pg8::EpiScaleBf16 E{(bf16*)(ws + R_Z), DIN0, SSQA, 0, 0, ZC_Q / 256, ZC_K / 256, SWA_C2};
        pg8::gemm_phase<pg8::EpiScaleBf16, pg8::StaticOrder, true, true, false>(F.lds, g, S, E); } SEAM(1);
    if (IN(2)) { l0_mixer_naive(F, args); } SEAM(2);
    if (IN(3)) { pg8::Gemm g{(const bf16*)(ws + R_MIX), (const bf16*)(ws + W_OUT), D, 0, D}; pg8::StaticOrder S; S.init(M, D, F.G, bx);
        pg8::EpiRes<false> E{args.in[0], F.H, XBA, SSQB, nullptr, nullptr};
        pg8::gemm_phase<pg8::EpiRes<false>, pg8::StaticOrder, false, true, false>(F.lds, g, S, E); } SEAM(3);
    if (IN(4)) { pg8::Gemm g{XBA, (const bf16*)(ws + W_GU0), D, 0, D}; pg8::StaticOrder S; S.init(M, 2 * DFF0, F.G, bx);
        pg8::EpiSwiGLU<false> E{(bf16*)(ws + R_HM0), DFF0, SSQB};
        pg8::gemm_phase<pg8::EpiSwiGLU<false>, pg8::StaticOrder, true, true, false>(F.lds, g, S, E); } SEAM(4);
    if (IN(5)) { pg8::Gemm g{(const bf16*)(ws + R_HM0), (const bf16*)(ws + W_D0), DFF0, 0, DFF0}; pg8::StaticOrder S; S.init(M, D, F.G, bx);
        pg8::EpiRes<false> E{F.H, F.H, XBA, SSQA, nullptr, nullptr};
        pg8::gemm_phase<pg8::EpiRes<false>, pg8::StaticOrder, false, true, false>(F.lds, g, S, E); } SEAM(5);
    if (IN(6)) {
        { pg8::Gemm g{(const bf16*)(ws + R_PB0), (const bf16*)(ws + W_PP0), PLE, 0, PLE}; pg8::StaticOrder S; S.init(M, D, F.G, bx);
          pg8::EpiPP E{(bf16*)(ws + R_PP)};
          pg8::gemm_phase<pg8::EpiPP, pg8::StaticOrder, false, true, false>(F.lds, g, S, E); }
        { pg8::Gemm g{XBA, (const bf16*)(ws + W_PG0), D, 0, D}; pg8::StaticOrder S; S.init(M, D, F.G, bx);
          pg8::EpiRes<true> E{F.H, F.H, XBB, SSQB, SSQA, (const bf16*)(ws + R_PP)};
          pg8::gemm_phase<pg8::EpiRes<true>, pg8::StaticOrder, false, true, false>(F.lds, g, S, E); }
    } SEAM(6);
    if (IN(7)) { pg8::Gemm g{XBB, (const bf16*)(ws + W_QKV), D, 0, D}; pg8::StaticOrder S; S.init(M, 3 * D, F.G, bx);
        pg8::EpiScaleBf16 E{(bf16*)(ws + R_Q), D, SSQB, D, (size_t)(R_K - R_Q) / 2, 0, 4, MOBA_C2};
        pg8::gemm_phase<pg8::EpiScaleBf16, pg8::StaticOrder, true, true, false>(F.lds, g, S, E); } SEAM(7);
    if (IN(8)) { l1_kmean(F); } SEAM(8);
    if (IN(9)) { l1_moba_select(F); } SEAM(9);
    if (IN(10)) { l1_moba_partial(F, args); } SEAM(10);
    if (IN(11)) { l1_moba_own_merge(F, args); } SEAM(11);
    if (IN(12)) { pg8::Gemm g{(const bf16*)(ws + R_ATT), (const bf16*)(ws + W_O), D, 0, D}; pg8::StaticOrder S; S.init(M, D, F.G, bx);
        pg8::EpiRes<false> E{F.H, F.H, XBA, nullptr, nullptr, nullptr};
        pg8::gemm_phase<pg8::EpiRes<false>, pg8::StaticOrder, false, true, false>(F.lds, g, S, E); } SEAM(12);
    if (IN(13)) { l1_route(F, args); } SEAM(13);
    if (IN(14)) { pg8::Gemm g{XBA, (const bf16*)(ws + W_EGU), D, (size_t)2 * DFE * D, D}; pg8::MoeOrder S; S.init((const int*)(F.ctl + CW_ECNT), 2 * DFE / 256, F.G, bx, (const int*)(ws + WS_TOKE), 0);
        pg8::EpiSwiGLU<true> E{(bf16*)(ws + R_HMG), DFE, (const float*)(ws + WS_RSE)};
        pg8::gemm_phase<pg8::EpiSwiGLU<true>, pg8::MoeOrder, true, true, true>(F.lds, g, S, E); } SEAM(14);
    if (IN(15)) {
        { pg8::Gemm g{(const bf16*)(ws + R_HMG), (const bf16*)(ws + W_ED), DFE, (size_t)D * DFE, DFE}; pg8::MoeOrder S; S.init((const int*)(F.ctl + CW_ECNT), D / 256, F.G, bx, nullptr, MOE_SUB_TILES);
          pg8::EpiMoeDown E{(bf16*)(ws + R_Y), (const float*)(ws + WS_GWE)};
          pg8::gemm_phase<pg8::EpiMoeDown, pg8::MoeOrder, true, true, false>(F.lds, g, S, E); }
        { pg8::Gemm g{(const bf16*)(ws + R_HMG), (const bf16*)(ws + W_ED), DFE / MOE_NKC, (size_t)D * DFE, DFE}; pg8::MoeSubOrder S; S.init((const int*)(F.ctl + CW_ECNT), D / 256, F.G, bx, MOE_SUB_TILES, MOE_NKC);
          pg8::EpiMoePartial E{(float*)(ws + R_YP), (const float*)(ws + WS_GWE), S.O.nM, (size_t)MOE_SUB_TILES * 256 * D};
          pg8::gemm_phase<pg8::EpiMoePartial, pg8::MoeSubOrder, true, true, false>(F.lds, g, S, E); }
    } SEAM(15);
    if (IN(16)) { l1_combine(F, args); } SEAM(16);
    if (IN(17)) {
        { pg8::Gemm g{(const bf16*)(ws + R_PB1), (const bf16*)(ws + W_PP1), PLE, 0, PLE}; pg8::StaticOrder S; S.init(M, D, F.G, bx);
          pg8::EpiPP E{(bf16*)(ws + R_PP1)};
          pg8::gemm_phase<pg8::EpiPP, pg8::StaticOrder, false, true, false>(F.lds, g, S, E); }
        { pg8::Gemm g{XBA, (const bf16*)(ws + W_PG1), D, 0, D}; pg8::StaticOrder S; S.init(M, D, F.G, bx);
          pg8::EpiRes<true> E{F.H, F.H, nullptr, SSQB, SSQA, (const bf16*)(ws + R_PP1)};
          pg8::gemm_phase<pg8::EpiRes<true>, pg8::StaticOrder, false, true, false>(F.lds, g, S, E); }
    } SEAM(17);
    if (IN(18)) { final_norm(F, args); }
#undef IN
#undef SEAM
}

extern "C" void kernel_launch(void* const* d_in, const int* in_sizes, int n_in, void* d_out, int out_size, void* d_ws, size_t ws_size, hipStream_t stream) {
    static int grid = 0;
    if (grid == 0) {
        if (n_in != 27 || in_sizes[0] != M * D || out_size != M * D || ws_size < WS_END) { fprintf(stderr, "kernel_launch: unexpected problem (n_in %d, in0 %d, out %d, ws %zu < %zu); nothing launched\n", n_in, n_in > 0 ? in_sizes[0] : -1, out_size, ws_size, (size_t)WS_END); grid = -1; return; }
        int dev = 0, cus = 0, per_cu = 0;
        if (hipGetDevice(&dev) != hipSuccess || hipDeviceGetAttribute(&cus, hipDeviceAttributeMultiprocessorCount, dev) != hipSuccess) { grid = -1; return; }
        if (hipFuncSetAttribute((const void*)trunk_fwd, hipFuncAttributeMaxDynamicSharedMemorySize, LDS_BYTES) != hipSuccess) { fprintf(stderr, "kernel_launch: hipFuncSetAttribute failed\n"); grid = -1; return; }
        if (hipOccupancyMaxActiveBlocksPerMultiprocessor(&per_cu, (const void*)trunk_fwd, NWAVES * 64, LDS_BYTES) != hipSuccess || per_cu < 1) fprintf(stderr, "kernel_launch: occupancy query reports %d\n", per_cu);
        (void)hipGetLastError();
        grid = cus;
        if (grid != 256) { fprintf(stderr, "kernel_launch: built for 256 CUs, found %d; nothing launched\n", cus); grid = -1; return; }
    }
    if (grid < 0) return;
    if (hipMemsetAsync((char*)d_ws + WS_CTL, 0, CTL_ZERO_BYTES, stream) != hipSuccess) return;
    Args a{};
    for (int i = 0; i < 27; ++i) a.in[i] = (const float*)d_in[i];
    a.out = (float*)d_out; a.ws = (unsigned char*)d_ws;
#if MK_ONE_LAUNCH
    a.ph_lo = 0; a.ph_hi = N_PHASES;
    hipLaunchKernelGGL(trunk_fwd, dim3(grid), dim3(NWAVES * 64), LDS_BYTES, stream, a);
#else
    for (int ph = 0; ph < N_PHASES; ++ph) for (int r = 0; r < (ph == PROBE_PHASE ? PROBE_CNT : 1); ++r) { a.ph_lo = ph; a.ph_hi = ph + 1; hipLaunchKernelGGL(trunk_fwd, dim3(grid), dim3(NWAVES * 64), LDS_BYTES, stream, a); }
#endif
}
```

```cpp
#include <hip/hip_runtime.h>
#include <cstdio>
#include <cstdint>

#ifndef PROBE_PHASE
#define PROBE_PHASE (-1)
#define PROBE_CNT 1
#endif
#ifndef MK_ONE_LAUNCH
#define MK_ONE_LAUNCH 1
#endif

namespace pg8 {
#define PG8_LAS __attribute__((address_space(3)))
typedef unsigned short bf16_t;
typedef short bf16x8 __attribute__((ext_vector_type(8)));
typedef float f32x4 __attribute__((ext_vector_type(4)));
typedef float f32x2 __attribute__((ext_vector_type(2)));
typedef unsigned u32x4 __attribute__((ext_vector_type(4)));
typedef unsigned u32x2 __attribute__((ext_vector_type(2)));
constexpr int BM = 256, BK = 64, HALF = 128, HTB = HALF * BK * 2, STAGE_BYTES = 8 * HTB, NXCD = 8, WGM = 8;

__host__ __device__ __forceinline__ int lds_byte(int r, int c) { const int st = (r >> 4) * 2 + (c >> 5), rr = r & 15, cc = c & 31, ob = rr * 64 + cc * 2; return st * 1024 + (ob ^ (((ob >> 9) & 1) << 5)); }
__host__ __device__ __forceinline__ void stage_rc(int b, int& R, int& C) { const int st = b / 1024, sb = b % 1024, swz = sb ^ (((sb >> 9) & 1) << 5); R = (st >> 1) * 16 + swz / 64; C = (st & 1) * 32 + (swz % 64) / 2; }
__host__ __device__ __forceinline__ int perm32(int rho) { const int n = rho >> 4, i = rho & 15; return 8 * (i >> 2) + 4 * n + (i & 3); }

struct Unit { int pm, pn, e, mt, nv, kc; };
struct Gemm { const bf16_t* A; const bf16_t* Bt; int K; size_t bslab; int ld; };

__device__ __forceinline__ void map_tile(int L, int nwg, int nM, int nN, int& pm, int& pn) {
    int wgid = L; { const int q = nwg / NXCD, r = nwg % NXCD, xcd = wgid % NXCD, off = wgid / NXCD; wgid = (xcd < r ? xcd * (q + 1) : r * (q + 1) + (xcd - r) * q) + off; }
    const int nig = WGM * nN, gid = wgid / nig, fm = gid * WGM, gsz = (nM - fm) < WGM ? (nM - fm) : WGM;
    pm = fm + ((wgid % nig) % gsz); pn = (wgid % nig) / gsz;
}
struct StaticOrder {
    int nM, nN, nwg, G, c;
    __device__ __forceinline__ void init(int M, int N, int G_, int c_) { nM = M / BM; nN = N / BM; nwg = nM * nN; G = G_; c = c_; }
    __device__ __forceinline__ bool next(int i, Unit& u) const {
        const long L = (long)i * G + c; if (L >= nwg) return false;
        map_tile((int)L, nwg, nM, nN, u.pm, u.pn); u.e = 0; u.mt = u.pm; u.nv = 256; u.kc = 0; return true;
    }
    __device__ __forceinline__ int arow(const Unit& u, int r) const { return u.pm * BM + r; }
};
struct MoeTiles {
    int c0, c1, c2, c3, c4, c5, c6, c7, t1, t2, t3, t4, t5, t6, t7, t8;
    __device__ __forceinline__ static int clampc(int v) { return v < 0 ? 0 : (v > 16384 ? 16384 : v); }
    __device__ __forceinline__ void init(const int* cntp) {
        c0 = clampc(cntp[0]); c1 = clampc(cntp[1]); c2 = clampc(cntp[2]); c3 = clampc(cntp[3]); c4 = clampc(cntp[4]); c5 = clampc(cntp[5]); c6 = clampc(cntp[6]); c7 = clampc(cntp[7]);
        t1 = (c0 + 255) >> 8; t2 = t1 + ((c1 + 255) >> 8); t3 = t2 + ((c2 + 255) >> 8); t4 = t3 + ((c3 + 255) >> 8); t5 = t4 + ((c4 + 255) >> 8); t6 = t5 + ((c5 + 255) >> 8); t7 = t6 + ((c6 + 255) >> 8); t8 = t7 + ((c7 + 255) >> 8);
    }
    __device__ __forceinline__ int base_of(int e) const { return e == 0 ? 0 : e == 1 ? t1 : e == 2 ? t2 : e == 3 ? t3 : e == 4 ? t4 : e == 5 ? t5 : e == 6 ? t6 : t7; }
    __device__ __forceinline__ int cnt_of(int e) const { return e == 0 ? c0 : e == 1 ? c1 : e == 2 ? c2 : e == 3 ? c3 : e == 4 ? c4 : e == 5 ? c5 : e == 6 ? c6 : c7; }
    __device__ __forceinline__ int expert_of(int pm) const { return (pm >= t1) + (pm >= t2) + (pm >= t3) + (pm >= t4) + (pm >= t5) + (pm >= t6) + (pm >= t7); }
};
struct MoeOrder {
    MoeTiles T; int nN, nwg, G, c, nM; const int* tok;
    __device__ __forceinline__ void init(const int* cntp, int nN_, int G_, int c_, const int* tok_, int lim_sub) { T.init(cntp); int nl = T.t8 - 128; nl = nl < 0 ? 0 : (nl > lim_sub ? lim_sub : nl); nM = T.t8 - nl; nN = nN_; nwg = nM * nN_; G = G_; c = c_; tok = tok_; }
    __device__ __forceinline__ void fill(Unit& u) const { const int e = T.expert_of(u.pm); u.e = e; u.mt = u.pm - T.base_of(e); const int rem = T.cnt_of(e) - u.mt * 256; u.nv = rem > 256 ? 256 : rem; }
    __device__ __forceinline__ bool next(int i, Unit& u) const {
        const long L = (long)i * G + c; if (L >= nwg) return false;
        map_tile((int)L, nwg, nM, nN, u.pm, u.pn); u.kc = 0; fill(u); return true;
    }
    __device__ __forceinline__ int arow(const Unit& u, int r) const { return r < u.nv ? tok[u.e * 16384 + u.mt * 256 + r] : 0; }
};
struct MoeSubOrder {
    MoeOrder O; int nsub, nkc;
    __device__ __forceinline__ void init(const int* cntp, int nN_, int G_, int c_, int lim_sub, int nkc_) { O.init(cntp, nN_, G_, c_, nullptr, lim_sub); nkc = nkc_; nsub = (O.T.t8 - O.nM) * nN_ * nkc_; }
    __device__ __forceinline__ bool next(int i, Unit& u) const {
        const long L = (long)i * O.G + O.c; if (L >= nsub) return false;
        const int l = (int)L; u.kc = l % nkc; const int r = l / nkc; u.pn = r % O.nN; u.pm = O.nM + r / O.nN; O.fill(u); return true;
    }
    __device__ __forceinline__ int arow(const Unit& u, int r) const { return 0; }
};

__device__ __forceinline__ unsigned cvt_pk_bf16(float lo, float hi) { unsigned r; asm volatile("v_cvt_pk_bf16_f32 %0, %1, %2" : "=v"(r) : "v"(lo), "v"(hi)); return r; }
__device__ __forceinline__ float rstd_of(const float* ssq4, int row) { const f32x4 s = *(const f32x4*)(ssq4 + 4 * (size_t)row); return rsqrtf(((s[0] + s[1]) + (s[2] + s[3])) * (1.0f / 1024.0f) + 1e-6f); }
__device__ __forceinline__ float rstd_from(const f32x4 s) { return rsqrtf(((s[0] + s[1]) + (s[2] + s[3])) * (1.0f / 1024.0f) + 1e-6f); }
__device__ __forceinline__ float silu_f(float x) { return x * __builtin_amdgcn_rcpf(1.0f + __expf(-x)); }
__device__ __forceinline__ float sigmoid_f(float x) { return __builtin_amdgcn_rcpf(1.0f + __expf(-x)); }

struct EpiScaleBf16 {
    static constexpr bool PERM = true, AFTER_DRAIN = false;
    bf16_t* O; int ldc; const float* ssq4; int split_cols; size_t split_stride; int sc_lo, sc_hi; float scale0;
    __device__ __forceinline__ void operator()(const f32x4 (&acc)[2][2][4][2], const Unit& u, int wr, int wc, int fr, int fq) const {
        const int row0 = u.pm * BM + wr * 64 + fr; int colt = u.pn * BM; bf16_t* base = O; const float sc = (u.pn >= sc_lo && u.pn < sc_hi) ? scale0 : 1.f;
        if (split_cols) { const int t = colt / split_cols; base += (size_t)t * split_stride; colt -= t * split_cols; }
        const int col0 = colt + wc * 32 + 8 * fq;
        f32x4 sq[2][4];
#pragma unroll
        for (int ai = 0; ai < 2; ++ai)
#pragma unroll
            for (int m = 0; m < 4; ++m) sq[ai][m] = *(const f32x4*)(ssq4 + 4 * (size_t)(row0 + ai * HALF + m * 16));
#pragma unroll
        for (int ai = 0; ai < 2; ++ai)
#pragma unroll
            for (int m = 0; m < 4; ++m) { const int row = row0 + ai * HALF + m * 16; const float rs = rstd_from(sq[ai][m]) * sc; bf16_t* rowp = base + (size_t)row * ldc + col0;
#pragma unroll
                for (int bj = 0; bj < 2; ++bj) { const f32x4 v0 = acc[ai][bj][m][0] * rs, v1 = acc[ai][bj][m][1] * rs;
                    u32x4 w; w.x = cvt_pk_bf16(v0[0], v0[1]); w.y = cvt_pk_bf16(v0[2], v0[3]); w.z = cvt_pk_bf16(v1[0], v1[1]); w.w = cvt_pk_bf16(v1[2], v1[3]);
                    *(u32x4*)(rowp + bj * HALF) = w; } }
    }
};
template <bool MOE> struct EpiSwiGLU {
    static constexpr bool PERM = true, AFTER_DRAIN = false;
    bf16_t* O; int ldo; const float* rs_src;
    __device__ __forceinline__ void operator()(const f32x4 (&acc)[2][2][4][2], const Unit& u, int wr, int wc, int fr, int fq) const {
        const int col0 = u.pn * HALF + wc * 32 + 8 * fq;
        float rsv[2][4];
#pragma unroll
        for (int ai = 0; ai < 2; ++ai)
#pragma unroll
            for (int m = 0; m < 4; ++m) { const int rl = ai * HALF + wr * 64 + m * 16 + fr;
                if (MOE) rsv[ai][m] = rl < u.nv ? rs_src[u.e * 16384 + u.mt * 256 + rl] : 0.f;
                else { const f32x4 s = *(const f32x4*)(rs_src + 4 * (size_t)(u.pm * BM + rl)); rsv[ai][m] = ((s[0] + s[1]) + (s[2] + s[3])); } }
#pragma unroll
        for (int ai = 0; ai < 2; ++ai)
#pragma unroll
            for (int m = 0; m < 4; ++m) { const int rl = ai * HALF + wr * 64 + m * 16 + fr; const int row = u.pm * BM + rl;
                const float rs = MOE ? rsv[ai][m] : rsqrtf(rsv[ai][m] * (1.0f / 1024.0f) + 1e-6f);
                const f32x4 g0 = acc[ai][0][m][0] * rs, g1 = acc[ai][0][m][1] * rs, u0 = acc[ai][1][m][0] * rs, u1 = acc[ai][1][m][1] * rs;
                u32x4 w;
                w.x = cvt_pk_bf16(silu_f(g0[0]) * u0[0], silu_f(g0[1]) * u0[1]); w.y = cvt_pk_bf16(silu_f(g0[2]) * u0[2], silu_f(g0[3]) * u0[3]);
                w.z = cvt_pk_bf16(silu_f(g1[0]) * u1[0], silu_f(g1[1]) * u1[1]); w.w = cvt_pk_bf16(silu_f(g1[2]) * u1[2], silu_f(g1[3]) * u1[3]);
                *(u32x4*)(O + (size_t)row * ldo + col0) = w; }
    }
};
struct EpiMoeDown {
    static constexpr bool PERM = true, AFTER_DRAIN = false;
    bf16_t* Y; const float* gw;
    __device__ __forceinline__ void operator()(const f32x4 (&acc)[2][2][4][2], const Unit& u, int wr, int wc, int fr, int fq) const {
        const int col0 = u.pn * BM + wc * 32 + 8 * fq;
        float gv[2][4];
#pragma unroll
        for (int ai = 0; ai < 2; ++ai)
#pragma unroll
            for (int m = 0; m < 4; ++m) { const int rl = ai * HALF + wr * 64 + m * 16 + fr; gv[ai][m] = rl < u.nv ? gw[u.e * 16384 + u.mt * 256 + rl] : 0.f; }
#pragma unroll
        for (int ai = 0; ai < 2; ++ai)
#pragma unroll
            for (int m = 0; m < 4; ++m) { const int rl = ai * HALF + wr * 64 + m * 16 + fr; const int row = u.pm * BM + rl;
                const float g = gv[ai][m];
#pragma unroll
                for (int bj = 0; bj < 2; ++bj) { const f32x4 v0 = acc[ai][bj][m][0] * g, v1 = acc[ai][bj][m][1] * g;
                    u32x4 w; w.x = cvt_pk_bf16(v0[0], v0[1]); w.y = cvt_pk_bf16(v0[2], v0[3]); w.z = cvt_pk_bf16(v1[0], v1[1]); w.w = cvt_pk_bf16(v1[2], v1[3]);
                    *(u32x4*)(Y + (size_t)row * 1024 + col0 + bj * HALF) = w; } }
    }
};
struct EpiMoePartial {
    static constexpr bool PERM = false, AFTER_DRAIN = false;
    float* YP; const float* gw; int pm0; size_t cstride;
    __device__ __forceinline__ void operator()(const f32x4 (&acc)[2][2][4][2], const Unit& u, int wr, int wc, int fr, int fq) const {
        const int col0 = u.pn * BM + wc * 32 + 4 * fq;
        float gv[2][4];
#pragma unroll
        for (int ai = 0; ai < 2; ++ai)
#pragma unroll
            for (int m = 0; m < 4; ++m) { const int rl = ai * HALF + wr * 64 + m * 16 + fr; gv[ai][m] = rl < u.nv ? gw[u.e * 16384 + u.mt * 256 + rl] : 0.f; }
        float* base = YP + (size_t)u.kc * cstride;
#pragma unroll
        for (int ai = 0; ai < 2; ++ai)
#pragma unroll
            for (int m = 0; m < 4; ++m) { const size_t off = (size_t)((u.pm - pm0) * BM + ai * HALF + wr * 64 + m * 16 + fr) * 1024 + col0;
#pragma unroll
                for (int bj = 0; bj < 2; ++bj)
#pragma unroll
                    for (int n = 0; n < 2; ++n) *(f32x4*)(base + off + bj * HALF + n * 16) = acc[ai][bj][m][n] * gv[ai][m]; }
    }
};
struct EpiPP {
    static constexpr bool PERM = false, AFTER_DRAIN = false;
    bf16_t* O;
    __device__ __forceinline__ void operator()(const f32x4 (&acc)[2][2][4][2], const Unit& u, int wr, int wc, int fr, int fq) const {
        const int col0 = u.pn * BM + wc * 32 + 4 * fq;
#pragma unroll
        for (int ai = 0; ai < 2; ++ai)
#pragma unroll
            for (int m = 0; m < 4; ++m) { const size_t off = (size_t)(u.pm * BM + ai * HALF + wr * 64 + m * 16 + fr) * 1024 + col0;
#pragma unroll
                for (int bj = 0; bj < 2; ++bj)
#pragma unroll
                    for (int n = 0; n < 2; ++n) { const f32x4 v = acc[ai][bj][m][n]; u32x2 w; w.x = cvt_pk_bf16(v[0], v[1]); w.y = cvt_pk_bf16(v[2], v[3]); *(u32x2*)(O + off + bj * HALF + n * 16) = w; } }
    }
};
template <bool PLE> struct EpiRes {
    static constexpr bool PERM = false, AFTER_DRAIN = true;
    static constexpr int NG = PLE ? 2 : 8, NB = 8 / NG;
    const bf16_t* Hin; bf16_t* Hb; float* Hf; float* ssq_out; const float* ssq_in; const bf16_t* PP;
    struct Pre { u32x2 h[NG][2][2]; u32x2 p[PLE ? NG : 1][2][2]; f32x4 sq[PLE ? NG : 1]; };
    __device__ __forceinline__ void preload(Pre& r, const Unit& u, int bt, int wr, int wc, int fr, int fq) const {
        const int col0 = u.pn * BM + wc * 32 + 4 * fq;
#pragma unroll
        for (int gi = 0; gi < NG; ++gi) { const int gm = bt * NG + gi, ai = gm >> 2, m = gm & 3; const int row = u.pm * BM + ai * HALF + wr * 64 + m * 16 + fr; const size_t off = (size_t)row * 1024 + col0;
            if (PLE) r.sq[gi] = *(const f32x4*)(ssq_in + 4 * (size_t)row);
#pragma unroll
            for (int bj = 0; bj < 2; ++bj)
#pragma unroll
                for (int n = 0; n < 2; ++n) { r.h[gi][bj][n] = *(const u32x2*)(Hin + off + bj * HALF + n * 16); if (PLE) r.p[gi][bj][n] = *(const u32x2*)(PP + off + bj * HALF + n * 16); } }
    }
    __device__ __forceinline__ void fused(f32x4 (&acc)[2][2][4][2], Pre& r, const Unit& u, int wr, int wc, int fr, int fq, PG8_LAS unsigned char* lds, int wid, int lane) const {
        PG8_LAS float* P = (PG8_LAS float*)lds;
        const int col0 = u.pn * BM + wc * 32 + 4 * fq;
#pragma unroll
        for (int bt = 0; bt < NB; ++bt) {
            if (bt > 0) preload(r, u, bt, wr, wc, fr, fq);
#pragma unroll
            for (int gi = 0; gi < NG; ++gi) { const int gm = bt * NG + gi, ai = gm >> 2, m = gm & 3;
                const int rl = ai * HALF + wr * 64 + m * 16 + fr; const int row = u.pm * BM + rl; const size_t off = (size_t)row * 1024 + col0;
                float rs = 0.f; if (PLE) rs = rstd_from(r.sq[gi]);
                float s = 0.f;
#pragma unroll
                for (int bj = 0; bj < 2; ++bj)
#pragma unroll
                    for (int n = 0; n < 2; ++n) { const size_t c = off + bj * HALF + n * 16; const u32x2 hw = r.h[gi][bj][n]; f32x4 v = acc[ai][bj][m][n];
                        const f32x4 hin = (f32x4){__uint_as_float(hw.x << 16), __uint_as_float(hw.x & 0xffff0000u), __uint_as_float(hw.y << 16), __uint_as_float(hw.y & 0xffff0000u)};
                        if (PLE) { const u32x2 pw = r.p[gi][bj][n];
                            const float p0 = __uint_as_float(pw.x << 16), p1 = __uint_as_float(pw.x & 0xffff0000u), p2 = __uint_as_float(pw.y << 16), p3 = __uint_as_float(pw.y & 0xffff0000u);
                            v[0] = hin[0] + sigmoid_f(v[0] * rs) * p0; v[1] = hin[1] + sigmoid_f(v[1] * rs) * p1; v[2] = hin[2] + sigmoid_f(v[2] * rs) * p2; v[3] = hin[3] + sigmoid_f(v[3] * rs) * p3;
                        } else v = hin + v;
                        if (Hf) *(f32x4*)(Hf + c) = v;
                        if (Hb) { u32x2 w; w.x = cvt_pk_bf16(v[0], v[1]); w.y = cvt_pk_bf16(v[2], v[3]); *(u32x2*)(Hb + c) = w; }
                        s += (v[0] * v[0] + v[1] * v[1]) + (v[2] * v[2] + v[3] * v[3]); }
                s += __shfl_xor(s, 16); s += __shfl_xor(s, 32);
                if (ssq_out && fq == 0) P[rl * 4 + wc] = s; }
            asm volatile("" ::: "memory");
        }
        if (ssq_out) {
            asm volatile("s_waitcnt lgkmcnt(0)" ::: "memory"); __builtin_amdgcn_s_barrier(); asm volatile("" ::: "memory");
            const int t = wid * 64 + lane;
            if (t < 256) { const f32x4 q = *(const PG8_LAS f32x4*)(P + t * 4); ssq_out[(size_t)(u.pm * BM + t) * 4 + u.pn] = (q[0] + q[1]) + (q[2] + q[3]); }
            asm volatile("s_waitcnt lgkmcnt(0)" ::: "memory"); __builtin_amdgcn_s_barrier(); asm volatile("" ::: "memory");
        }
    }
};

template <class Epi, class Sched, bool ALIGN_EPI, bool SP2, bool GATHER>
__device__ __forceinline__ void gemm_phase(PG8_LAS unsigned char* lds, const Gemm g, const Sched& S, const Epi& E) {
    int tid_ = threadIdx.x; asm volatile("" : "+v"(tid_));
    const int tid = tid_, wid = __builtin_amdgcn_readfirstlane(tid >> 6), lane = tid & 63, wr = wid >> 2, wc = wid & 3, fr = lane & 15, fq = lane >> 4;
    const int K = g.K, nt = K / BK, LD = g.ld;
    unsigned voffA[2], voffB[2]; int aR[2], aC[2];
#pragma unroll
    for (int i = 0; i < 2; ++i) { int R, C; stage_rc(tid * 16 + i * 8192, R, C); const int Rb = Epi::PERM ? ((R & ~31) + perm32(R & 31)) : R;
        voffA[i] = (unsigned)(R * LD + C) * 2u; voffB[i] = (unsigned)(Rb * LD + C) * 2u; aR[i] = R; aC[i] = C; }
    const size_t kstep = (size_t)(BK * 2);
    const size_t hstep = (size_t)HALF * LD * 2;
    const size_t tstep = 2 * hstep;
    const unsigned ldsw = (unsigned)wid * 1024u;
    const int aoff = lds_byte(wr * 64 + fr, fq * 8), boff = lds_byte(wc * 32 + fr, fq * 8);
    unsigned gcur[2][2], gnxt[2][2];
#define PG8_SA(b, h) (((b) * 2 + (h)) * HTB)
#define PG8_SB(b, h) ((4 + (b) * 2 + (h)) * HTB)
#define PG8_STAGE(bufoff, gbase, voff) do { _Pragma("unroll") for (int _i = 0; _i < 2; ++_i) \
        __builtin_amdgcn_global_load_lds((const unsigned*)((const char*)(gbase) + (voff)[_i]), (PG8_LAS unsigned*)(lds + (bufoff) + ldsw + _i * 8192), 16, 0, 0); } while (0)
#define PG8_STAGE_A(bufoff, p, h, NX) do { if constexpr (GATHER) { unsigned _vo[2]; _vo[0] = (NX) ? gnxt[h][0] : gcur[h][0]; _vo[1] = (NX) ? gnxt[h][1] : gcur[h][1]; PG8_STAGE(bufoff, p, _vo); } \
        else { PG8_STAGE(bufoff, (p) + (h) * hstep, voffA); } } while (0)
#define PG8_GOFF(dst, uu) do { _Pragma("unroll") for (int _h = 0; _h < 2; ++_h) _Pragma("unroll") for (int _i = 0; _i < 2; ++_i) \
        dst[_h][_i] = ((unsigned)S.arow(uu, _h * HALF + aR[_i]) * (unsigned)LD + (unsigned)aC[_i]) * 2u; } while (0)
#define PG8_LDA(dst, b, h) do { _Pragma("unroll") for (int m = 0; m < 4; ++m) _Pragma("unroll") for (int k = 0; k < 2; ++k) dst[m][k] = *(const PG8_LAS bf16x8*)(lds + PG8_SA(b, h) + aoff + m * 2048 + k * 1024); } while (0)
#define PG8_LDB(dst, b, h) do { _Pragma("unroll") for (int n = 0; n < 2; ++n) _Pragma("unroll") for (int k = 0; k < 2; ++k) dst[n][k] = *(const PG8_LAS bf16x8*)(lds + PG8_SB(b, h) + boff + n * 2048 + k * 1024); } while (0)
#define PG8_MMA(ai, bj, At, Bt) do { __builtin_amdgcn_s_setprio(1); _Pragma("unroll") for (int m = 0; m < 4; ++m) _Pragma("unroll") for (int n = 0; n < 2; ++n) _Pragma("unroll") for (int k = 0; k < 2; ++k) \
        acc[ai][bj][m][n] = __builtin_amdgcn_mfma_f32_16x16x32_bf16(Bt[n][k], At[m][k], acc[ai][bj][m][n], 0, 0, 0); __builtin_amdgcn_s_setprio(0); } while (0)
#define PG8_WAIT_V(n) asm volatile("s_waitcnt vmcnt(" #n ")" ::: "memory")
#define PG8_WAIT_L(n) asm volatile("s_waitcnt lgkmcnt(" #n ")" ::: "memory")
#define PG8_BAR __builtin_amdgcn_s_barrier()
#define PG8_SCHED __builtin_amdgcn_sched_barrier(0)
    Unit cur, nxt; int ui = 0;
    if (!S.next(0, cur)) return;
    f32x4 acc[2][2][4][2];
#pragma unroll
    for (int a = 0; a < 2; ++a)
#pragma unroll
        for (int b = 0; b < 2; ++b)
#pragma unroll
            for (int m = 0; m < 4; ++m)
#pragma unroll
                for (int n = 0; n < 2; ++n) acc[a][b][m][n] = (f32x4){0.f, 0.f, 0.f, 0.f};
    bf16x8 At[4][2], B0[2][2], B1[2][2];
    const char* cA = GATHER ? (const char*)g.A : (const char*)g.A + (size_t)cur.pm * tstep + (size_t)cur.kc * K * 2;
    const char* cB = (const char*)g.Bt + ((size_t)cur.e * g.bslab) * 2 + (size_t)cur.pn * tstep + (size_t)cur.kc * K * 2;
    if constexpr (GATHER) { PG8_GOFF(gcur, cur); PG8_GOFF(gnxt, cur); }
    if constexpr (SP2) {
        PG8_STAGE(PG8_SB(0, 0), cB, voffB); PG8_STAGE(PG8_SB(0, 1), cB + hstep, voffB); PG8_STAGE_A(PG8_SA(0, 0), cA, 0, false); PG8_STAGE_A(PG8_SA(0, 1), cA, 1, false);
        if (wr == 1) PG8_BAR;
        PG8_WAIT_V(2); PG8_BAR;
        PG8_STAGE(PG8_SB(1, 0), cB + kstep, voffB); PG8_STAGE_A(PG8_SA(1, 0), cA + kstep, 0, false); PG8_STAGE(PG8_SB(1, 1), cB + hstep + kstep, voffB);
        PG8_WAIT_V(6); PG8_BAR;
    } else {
        PG8_STAGE(PG8_SB(0, 0), cB, voffB); PG8_STAGE_A(PG8_SA(0, 0), cA, 0, false); PG8_STAGE(PG8_SB(0, 1), cB + hstep, voffB); PG8_STAGE_A(PG8_SA(0, 1), cA, 1, false);
        if (wr == 1) PG8_BAR;
        PG8_WAIT_V(4); PG8_BAR;
        PG8_STAGE(PG8_SB(1, 0), cB + kstep, voffB); PG8_STAGE_A(PG8_SA(1, 0), cA + kstep, 0, false); PG8_STAGE(PG8_SB(1, 1), cB + hstep + kstep, voffB);
        PG8_WAIT_V(6); PG8_BAR;
    }
    for (;;) {
        const bool has_next = S.next(ui + 1, nxt);
        const char* nA = GATHER ? (const char*)g.A : (has_next ? (const char*)g.A + (size_t)nxt.pm * tstep + (size_t)nxt.kc * K * 2 : cA);
        const char* nB = has_next ? (const char*)g.Bt + ((size_t)nxt.e * g.bslab) * 2 + (size_t)nxt.pn * tstep + (size_t)nxt.kc * K * 2 : cB;
        if constexpr (GATHER) { if (has_next) { PG8_GOFF(gnxt, nxt); } else {
#pragma unroll
            for (int _h = 0; _h < 2; ++_h)
#pragma unroll
                for (int _i = 0; _i < 2; ++_i) gnxt[_h][_i] = gcur[_h][_i]; } }
        for (int t = 0; t < nt; t += 2) {
            const bool last = (t == nt - 2);
            const char* a1 = cA + (size_t)(t + 1) * kstep;
            const char* a2 = last ? nA : cA + (size_t)(t + 2) * kstep; const char* b2 = last ? nB : cB + (size_t)(t + 2) * kstep;
            const char* a3 = a2 + kstep; const char* b3 = b2 + kstep;
            if constexpr (SP2) {
            PG8_LDB(B0, 0, 0); PG8_LDB(B1, 0, 1); PG8_SCHED; PG8_LDA(At, 0, 0); PG8_STAGE_A(PG8_SA(1, 1), a1, 1, false);
            PG8_WAIT_V(8); PG8_WAIT_L(0); PG8_BAR; PG8_MMA(0, 0, At, B0); PG8_MMA(0, 1, At, B1); PG8_BAR; PG8_SCHED;
            PG8_LDA(At, 0, 1); PG8_STAGE(PG8_SB(0, 0), b2, voffB); PG8_STAGE(PG8_SB(0, 1), b2 + hstep, voffB); PG8_STAGE_A(PG8_SA(0, 0), a2, 0, last);
            PG8_WAIT_V(8); PG8_WAIT_L(0); PG8_BAR; PG8_MMA(1, 0, At, B0); PG8_MMA(1, 1, At, B1); PG8_BAR; PG8_SCHED;
            PG8_LDB(B0, 1, 0); PG8_LDB(B1, 1, 1); PG8_SCHED; PG8_LDA(At, 1, 0); PG8_STAGE_A(PG8_SA(0, 1), a2, 1, last);
            PG8_WAIT_V(8); PG8_WAIT_L(0); PG8_BAR; PG8_MMA(0, 0, At, B0); PG8_MMA(0, 1, At, B1); PG8_BAR; PG8_SCHED;
            PG8_LDA(At, 1, 1); PG8_STAGE(PG8_SB(1, 0), b3, voffB); PG8_STAGE(PG8_SB(1, 1), b3 + hstep, voffB); PG8_STAGE_A(PG8_SA(1, 0), a3, 0, last);
            PG8_WAIT_V(8); PG8_WAIT_L(0); PG8_BAR; PG8_MMA(1, 0, At, B0); PG8_MMA(1, 1, At, B1); PG8_BAR; PG8_SCHED;
            } else {
            PG8_LDB(B0, 0, 0); PG8_SCHED; PG8_LDA(At, 0, 0); PG8_STAGE_A(PG8_SA(1, 1), a1, 1, false);
            PG8_WAIT_L(8); PG8_BAR; PG8_WAIT_L(0); PG8_MMA(0, 0, At, B0); PG8_BAR; PG8_SCHED;
            PG8_LDB(B1, 0, 1); PG8_STAGE(PG8_SB(0, 0), b2, voffB);
            PG8_BAR; PG8_WAIT_L(0); PG8_MMA(0, 1, At, B1); PG8_BAR;
            PG8_LDA(At, 0, 1); PG8_STAGE_A(PG8_SA(0, 0), a2, 0, last);
            PG8_BAR; PG8_WAIT_L(0); PG8_MMA(1, 0, At, B0); PG8_BAR; PG8_SCHED;
            PG8_STAGE(PG8_SB(0, 1), b2 + hstep, voffB);
            PG8_WAIT_V(6); PG8_BAR; PG8_MMA(1, 1, At, B1); PG8_BAR;
            PG8_LDB(B0, 1, 0); PG8_SCHED; PG8_LDA(At, 1, 0); PG8_STAGE_A(PG8_SA(0, 1), a2, 1, last);
            PG8_WAIT_L(8); PG8_BAR; PG8_WAIT_L(0); PG8_MMA(0, 0, At, B0); PG8_BAR; PG8_SCHED;
            PG8_LDB(B1, 1, 1); PG8_STAGE(PG8_SB(1, 0), b3, voffB);
            PG8_BAR; PG8_WAIT_L(0); PG8_MMA(0, 1, At, B1); PG8_BAR;
            PG8_LDA(At, 1, 1); PG8_STAGE_A(PG8_SA(1, 0), a3, 0, last);
            PG8_BAR; PG8_WAIT_L(0); PG8_MMA(1, 0, At, B0); PG8_BAR; PG8_SCHED;
            PG8_STAGE(PG8_SB(1, 1), b3 + hstep, voffB);
            PG8_WAIT_V(6); PG8_BAR; PG8_MMA(1, 1, At, B1); PG8_BAR;
            }
        }
        if constexpr (ALIGN_EPI) { if (wr == 0) PG8_BAR; }
        if constexpr (!Epi::AFTER_DRAIN) { E(acc, cur, wr, wc, fr, fq); }
        if (!has_next) break;
#pragma unroll
        for (int a = 0; a < 2; ++a)
#pragma unroll
            for (int b = 0; b < 2; ++b)
#pragma unroll
                for (int m = 0; m < 4; ++m)
#pragma unroll
                    for (int n = 0; n < 2; ++n) acc[a][b][m][n] = (f32x4){0.f, 0.f, 0.f, 0.f};
        cur = nxt; cA = nA; cB = nB; ++ui;
        if constexpr (GATHER) {
#pragma unroll
            for (int _h = 0; _h < 2; ++_h)
#pragma unroll
                for (int _i = 0; _i < 2; ++_i) gcur[_h][_i] = gnxt[_h][_i]; }
        if constexpr (ALIGN_EPI) { if (wr == 1) PG8_BAR; }
    }
    if constexpr (Epi::AFTER_DRAIN) {
        typename Epi::Pre pre; E.preload(pre, cur, 0, wr, wc, fr, fq);
        PG8_WAIT_V(0);
        if constexpr (!ALIGN_EPI) { if (wr == 0) PG8_BAR; }
        PG8_BAR;
        E.fused(acc, pre, cur, wr, wc, fr, fq, lds, wid, lane);
    } else {
        PG8_WAIT_V(0);
        if constexpr (!ALIGN_EPI) { if (wr == 0) PG8_BAR; }
        PG8_BAR;
    }
#undef PG8_SA
#undef PG8_SB
#undef PG8_STAGE
#undef PG8_STAGE_A
#undef PG8_GOFF
#undef PG8_LDA
#undef PG8_LDB
#undef PG8_MMA
#undef PG8_WAIT_V
#undef PG8_WAIT_L
#undef PG8_BAR
#undef PG8_SCHED
}
}

constexpr int NWAVES = 8;
constexpr int BATCH = 2, SEQ = 8192, M = BATCH * SEQ, D = 1024;
constexpr int DIN0 = 2304, DFF0 = 2816, DFE = 3584, NEXP = 8, PLE = 256;
constexpr int ZC_B = 0, ZC_C = 512, ZC_U = 1024, ZC_Q = 1536, ZC_K = 2048, ZC_V = 2176;
constexpr int HMG_ROWS = 34816;
constexpr float EPS = 1e-6f;

constexpr size_t MiB = 1u << 20;
constexpr size_t WS_CTL = 0, CTL_ZERO_BYTES = 1 * MiB;
constexpr size_t WS_SSQA = 1 * MiB, WS_SSQB = WS_SSQA + 256 * 1024;
constexpr size_t WS_TOKE = 2 * MiB, WS_GWE = WS_TOKE + 512 * 1024, WS_RSE = WS_GWE + 512 * 1024, WS_POS = WS_RSE + 512 * 1024;
constexpr size_t WS_KM = 4 * MiB;
constexpr size_t WS_W = 16 * MiB;
constexpr size_t W_IN = WS_W, W_OUT = W_IN + (size_t)DIN0 * D * 2, W_GU0 = W_OUT + (size_t)D * D * 2, W_D0 = W_GU0 + (size_t)2 * DFF0 * D * 2,
                 W_PG0 = W_D0 + (size_t)D * DFF0 * 2, W_PP0 = W_PG0 + (size_t)D * D * 2, W_QKV = W_PP0 + (size_t)D * PLE * 2, W_O = W_QKV + (size_t)3 * D * D * 2,
                 W_PG1 = W_O + (size_t)D * D * 2, W_PP1 = W_PG1 + (size_t)D * D * 2, W_EGU = W_PP1 + (size_t)D * PLE * 2, W_ED = W_EGU + (size_t)NEXP * 2 * DFE * D * 2,
                 W_END = W_ED + (size_t)NEXP * D * DFE * 2;
constexpr size_t WS_XBA = 220 * MiB;
constexpr size_t WS_R = 252 * MiB;
static_assert(W_END <= WS_XBA, "weights overflow");
constexpr size_t R_Z = WS_R, R_MIX = WS_R + 72 * MiB, R_HM0 = WS_R, R_XBB = WS_R + 104 * MiB, R_PP = WS_R + 136 * MiB, R_PB0 = WS_R + 168 * MiB;
constexpr size_t R_Q = WS_R, R_K = WS_R + 32 * MiB, R_V = WS_R + 64 * MiB, R_PO = WS_R + 96 * MiB, R_ML = WS_R + 192 * MiB, R_LIST = WS_R + 196 * MiB, R_ATT = R_Q, R_XBC = WS_R + 204 * MiB;
constexpr float MOBA_C2 = 0.08838834764831845f * 1.4426950408889634f;
constexpr float LOG2E = 1.4426950408889634f;
constexpr float SWA_C2 = 0.125f * 1.4426950408889634f;
constexpr size_t R_HMG = WS_R;
constexpr size_t R_Y = W_EGU;
constexpr size_t R_PB1 = WS_R, R_PP1 = WS_R + 8 * MiB;
constexpr int MOE_SUB_TILES = 6, MOE_NKC = 7;
constexpr size_t R_YP = R_Y + 68 * MiB;
static_assert(R_YP + (size_t)MOE_NKC * MOE_SUB_TILES * 256 * D * 4 <= W_ED, "YP overlay");
constexpr size_t WS_END = WS_R + 238 * MiB;
static_assert((size_t)HMG_ROWS * DFE * 2 <= 238 * MiB, "HMg");
static_assert((size_t)HMG_ROWS * D * 2 <= (size_t)NEXP * 2 * DFE * D * 2, "Y overlay");
constexpr int CW_BAR = 4096;
constexpr int CW_ECNT = 16384;
constexpr int CW_LCNT = 16384 + 64;

constexpr int RING_BYTES = 131072;
constexpr int LDS_BYTES = 147456;
constexpr int LDSCTL_OFF = LDS_BYTES - 1024, MISC_OFF = LDSCTL_OFF + 320;
static_assert(8 * 64 * 65 * 4 <= LDSCTL_OFF, "prologue scratch");

#define GAS __attribute__((address_space(1)))
#define LAS __attribute__((address_space(3)))
typedef unsigned short bf16;
typedef unsigned v4u __attribute__((ext_vector_type(4)));
typedef unsigned v2u __attribute__((ext_vector_type(2)));
typedef float f32x4 __attribute__((ext_vector_type(4)));
typedef GAS unsigned gu32;
#define RLX_AGENT __ATOMIC_RELAXED, __HIP_MEMORY_SCOPE_AGENT
#define LDS_WAIT() asm volatile("s_waitcnt lgkmcnt(0)" ::: "memory")
#define VM_WAIT() asm volatile("s_waitcnt vmcnt(0)" ::: "memory")
__device__ __forceinline__ unsigned pk2(float lo, float hi) { return pg8::cvt_pk_bf16(lo, hi); }
__device__ __forceinline__ float bflo(unsigned w) { return __uint_as_float(w << 16); }
__device__ __forceinline__ float bfhi(unsigned w) { return __uint_as_float(w & 0xffff0000u); }

#define XB_TMO      128
#define XB_XCNT(j)  (256  + 64 * (j))
#define XB_XSUB(j)  (1280 + 64 * (j))
#define XB_XGEN(j)  (2304 + 64 * (j))
#define XB_TOP      3328
#define XB_TOPGEN   3392
#define XCD_BAR_WORDS 3456
#define XB_SPIN_CAP (1u << 18)
__device__ __forceinline__ unsigned xb_ld(unsigned* p)              { return __hip_atomic_load(p, __ATOMIC_RELAXED, __HIP_MEMORY_SCOPE_AGENT); }
__device__ __forceinline__ unsigned xb_add(unsigned* p, unsigned v) { return __hip_atomic_fetch_add(p, v, __ATOMIC_RELAXED, __HIP_MEMORY_SCOPE_AGENT); }
__device__ __forceinline__ unsigned xb_xcc_id() { return (unsigned)__builtin_amdgcn_s_getreg((3 << 11) | 20) & 0xFu; }
#define XB_SPIN(cond, bar) do { unsigned _sp = 0; while (cond) { __builtin_amdgcn_s_sleep(1); \
    if ((++_sp & 255u) == 0u) { if (xb_ld(&(bar)[XB_TMO])) break; if (_sp > XB_SPIN_CAP) { atomicAdd(&(bar)[XB_TMO], 1u); break; } } } } while (0)
struct XcdBarrier { unsigned* bar; unsigned x; volatile LAS unsigned* st; };
__device__ __forceinline__ XcdBarrier xcd_barrier_post(unsigned* bar, volatile LAS unsigned* st) {
    XcdBarrier b; b.bar = bar; b.x = xb_xcc_id(); b.st = st;
    if (threadIdx.x == 0) (void)xb_add(&bar[XB_XCNT(b.x)], 1u);
    return b;
}
__device__ __forceinline__ void xcd_barrier_complete(unsigned* bar, unsigned x, unsigned& nloc, unsigned& nx) {
    const unsigned G = gridDim.x * gridDim.y * gridDim.z;
    unsigned sum, cnt, mine, sp = 0u;
    for (;;) {
        sum = 0u; cnt = 0u; mine = 0u;
#pragma unroll
        for (unsigned j = 0; j < 16; ++j) { const unsigned c = xb_ld(&bar[XB_XCNT(j)]); sum += c; cnt += (c > 0u) ? 1u : 0u; mine = (j == x) ? c : mine; }
        if (sum == G) break;
        __builtin_amdgcn_s_sleep(1);
        if ((++sp & 255u) == 0u) { if (xb_ld(&bar[XB_TMO])) break; if (sp > XB_SPIN_CAP) { atomicAdd(&bar[XB_TMO], 1u); break; } }
    }
    nloc = mine > 0u ? mine : 1u; nx = cnt > 0u ? cnt : 1u;
}
__device__ __forceinline__ void xcd_barrier(const XcdBarrier& b) {
    asm volatile("s_waitcnt vmcnt(0)" ::: "memory");
    __syncthreads();
    if (threadIdx.x == 0) {
        unsigned* bar = b.bar;
        __builtin_amdgcn_s_waitcnt(0);
        unsigned nloc = b.st[0], nx = b.st[1];
        if (nloc == 0u) { xcd_barrier_complete(bar, b.x, nloc, nx); b.st[0] = nloc; b.st[1] = nx; }
        const unsigned old = xb_add(&bar[XB_XSUB(b.x)], 1u);
        const unsigned gen = old / nloc;
        if (old + 1u == (gen + 1u) * nloc) {
            __builtin_amdgcn_fence(__ATOMIC_RELEASE, "agent");
            asm volatile("s_waitcnt vmcnt(0)" ::: "memory");
            const unsigned og = xb_add(&bar[XB_TOP], 1u);
            const unsigned tg = og / nx;
            if (og + 1u == (tg + 1u) * nx) xb_add(&bar[XB_TOPGEN], 1u);
            else XB_SPIN(xb_ld(&bar[XB_TOPGEN]) == tg, bar);
            __builtin_amdgcn_fence(__ATOMIC_ACQUIRE, "agent");
            xb_add(&bar[XB_XGEN(b.x)], 1u);
            asm volatile("s_waitcnt vmcnt(0)" ::: "memory");
        } else {
            XB_SPIN(xb_ld(&bar[XB_XGEN(b.x)]) == gen, bar);
            __builtin_amdgcn_fence(__ATOMIC_ACQUIRE, "agent");
            asm volatile("s_waitcnt vmcnt(0)" ::: "memory");
        }
    }
    __syncthreads();
}

struct Args { const float* in[27]; float* out; unsigned char* ws; int ph_lo, ph_hi; };
struct Frame {
    LAS unsigned char* lds;
    volatile LAS unsigned* MISC;
    gu32* ctl;
    int G;
    unsigned char* ws;
    float* H;
};
__device__ __forceinline__ float wave_sum(float v) {
#pragma unroll
    for (int o = 1; o < 64; o <<= 1) v += __shfl_xor(v, o);
    return v;
}
__device__ __forceinline__ float wave_max(float v) {
#pragma unroll
    for (int o = 1; o < 64; o <<= 1) v = fmaxf(v, __shfl_xor(v, o));
    return v;
}
__device__ __forceinline__ int t5_bucket(int d) {
    if (d < 16) return d;
    int b = 16;
    b += d >= 19; b += d >= 21; b += d >= 24; b += d >= 27; b += d >= 31; b += d >= 35; b += d >= 40; b += d >= 46;
    b += d >= 52; b += d >= 59; b += d >= 67; b += d >= 77; b += d >= 87; b += d >= 99; b += d >= 113;
    return b;
}
constexpr int TABN = 384, TAB_BYTES = 8 * TABN * 4;
template <int MODE> __device__ __forceinline__ void fill_tab(LAS float* tab, const float* rel_bias, int tid) {
    for (int i = tid; i < 8 * TABN; i += NWAVES * 64) { const int h = i / TABN, j = i - h * TABN, d = 319 - j; float v;
        const int dc = d < 0 ? 0 : (d > 127 ? 127 : d); const float b = rel_bias[t5_bucket(dc) * 8 + h];
        if (MODE == 0) v = (d >= 0 && d <= 127) ? b * 1.4426950408889634f : -INFINITY;
        else if (MODE == 1) v = d >= 0 ? b * 1.4426950408889634f : -INFINITY;
        else v = (b - rel_bias[31 * 8 + h]) * 1.4426950408889634f;
        tab[i] = v; }
}
typedef float f32x16_ __attribute__((ext_vector_type(16)));
__device__ __forceinline__ void bias_add(f32x16_& p0, f32x16_& p1, const LAS float* tb) {
#pragma unroll
    for (int i = 0; i < 16; ++i) { const int c = (i & 3) + 8 * (i >> 2); p0[i] += tb[c]; p1[i] += tb[c + 32]; }
}

constexpr int TSCR = 65, TSCR_BYTES = 64 * TSCR * 4;
__device__ __forceinline__ void p0_transpose_item(const float* W, int K, int N, const float* gain, bf16* WT, int mode, LAS float* scr, int item, int lane) {
    const int nblk = N / 64, kb = item / nblk, nb = item % nblk, k0 = 64 * kb, n0 = 64 * nb;
    const int lr = lane >> 4, lc = (lane & 15) * 4;
    f32x4 v[16];
#pragma unroll
    for (int i = 0; i < 16; ++i) v[i] = *(const GAS f32x4*)(W + (size_t)(k0 + 4 * i + lr) * N + n0 + lc);
    if (gain) {
#pragma unroll
        for (int i = 0; i < 16; ++i) v[i] = v[i] * gain[k0 + 4 * i + lr]; }
#pragma unroll
    for (int i = 0; i < 16; ++i) { LAS float* d = scr + (4 * i + lr) * TSCR + lc; d[0] = v[i].x; d[1] = v[i].y; d[2] = v[i].z; d[3] = v[i].w; }
    LDS_WAIT(); asm volatile("" ::: "memory");
    const int n8 = lane & 7, c = lane >> 3;
#pragma unroll
    for (int j = 0; j < 8; ++j) { const int n = n8 + 8 * j; const LAS float* s = scr + (8 * c) * TSCR + n;
        v4u o; o.x = pk2(s[0 * TSCR], s[1 * TSCR]); o.y = pk2(s[2 * TSCR], s[3 * TSCR]); o.z = pk2(s[4 * TSCR], s[5 * TSCR]); o.w = pk2(s[6 * TSCR], s[7 * TSCR]);
        const int nn = n0 + n; const int drow = mode == 0 ? nn : (256 * (nn >> 7) + (nn & 127) + (mode == 2 ? 128 : 0));
        *(GAS v4u*)(WT + (size_t)drow * K + k0 + 8 * c) = o; }
    LDS_WAIT(); asm volatile("" ::: "memory");
}
__device__ __forceinline__ float row_to_bf16_ssq(const float* xrow, bf16* orow, int lane) {
    const GAS f32x4* xr = (const GAS f32x4*)xrow + lane;
    f32x4 v[4]; float s = 0.f;
#pragma unroll
    for (int j = 0; j < 4; ++j) { v[j] = xr[64 * j]; s += (v[j].x * v[j].x + v[j].y * v[j].y) + (v[j].z * v[j].z + v[j].w * v[j].w); }
    GAS v2u* o8 = (GAS v2u*)orow + lane;
#pragma unroll
    for (int j = 0; j < 4; ++j) { v2u w; w.x = pk2(v[j].x, v[j].y); w.y = pk2(v[j].z, v[j].w); o8[64 * j] = w; }
    return wave_sum(s);
}
__device__ __forceinline__ void cvt_f32_bf16_flat(const float* src, bf16* dst, size_t n8, int gt, int ngt) {
    for (size_t i = gt; i < n8; i += ngt) { const f32x4 a = ((const GAS f32x4*)src)[2 * i], b = ((const GAS f32x4*)src)[2 * i + 1];
        v4u o; o.x = pk2(a.x, a.y); o.y = pk2(a.z, a.w); o.z = pk2(b.x, b.y); o.w = pk2(b.z, b.w); ((GAS v4u*)dst)[i] = o; }
}
__device__ __forceinline__ void p0_prologue(Frame& F, const Args& a) {
    int tid_ = threadIdx.x; asm volatile("" : "+v"(tid_)); const int tid = tid_, lane = tid & 63, wave = __builtin_amdgcn_readfirstlane(tid >> 6); (void)lane; (void)wave;
    LAS float* scr = (LAS float*)(F.lds + wave * TSCR_BYTES);
    const int gw = blockIdx.x * NWAVES + wave, NGW = F.G * NWAVES;
    unsigned char* ws = F.ws;
    constexpr int I_WIN = 16 * 36, I_SQ = 16 * 16, I_F0 = 16 * 44, I_D0 = 44 * 16, I_PP = 4 * 16, I_QKV = 16 * 48, I_EG = 16 * 56, I_ED = 56 * 16;
    constexpr int NITEMS = I_WIN + I_SQ + 2 * I_F0 + I_D0 + I_SQ + I_PP + I_QKV + I_SQ + I_SQ + I_PP + 8 * (2 * I_EG + I_ED);
    for (int it = gw; it < NITEMS; it += NGW) {
        int r = it;
        if (r < I_WIN) { p0_transpose_item(a.in[5], D, DIN0, a.in[4], (bf16*)(ws + W_IN), 0, scr, r, lane); continue; } r -= I_WIN;
        if (r < I_SQ) { p0_transpose_item(a.in[8], D, D, nullptr, (bf16*)(ws + W_OUT), 0, scr, r, lane); continue; } r -= I_SQ;
        if (r < I_F0) { p0_transpose_item(a.in[10], D, DFF0, a.in[9], (bf16*)(ws + W_GU0), 1, scr, r, lane); continue; } r -= I_F0;
        if (r < I_F0) { p0_transpose_item(a.in[11], D, DFF0, a.in[9], (bf16*)(ws + W_GU0), 2, scr, r, lane); continue; } r -= I_F0;
        if (r < I_D0) { p0_transpose_item(a.in[12], DFF0, D, nullptr, (bf16*)(ws + W_D0), 0, scr, r, lane); continue; } r -= I_D0;
        if (r < I_SQ) { p0_transpose_item(a.in[14], D, D, a.in[13], (bf16*)(ws + W_PG0), 0, scr, r, lane); continue; } r -= I_SQ;
        if (r < I_PP) { p0_transpose_item(a.in[15], PLE, D, nullptr, (bf16*)(ws + W_PP0), 0, scr, r, lane); continue; } r -= I_PP;
        if (r < I_QKV) { p0_transpose_item(a.in[17], D, 3 * D, a.in[16], (bf16*)(ws + W_QKV), 0, scr, r, lane); continue; } r -= I_QKV;
        if (r < I_SQ) { p0_transpose_item(a.in[18], D, D, nullptr, (bf16*)(ws + W_O), 0, scr, r, lane); continue; } r -= I_SQ;
        if (r < I_SQ) { p0_transpose_item(a.in[25], D, D, a.in[24], (bf16*)(ws + W_PG1), 0, scr, r, lane); continue; } r -= I_SQ;
        if (r < I_PP) { p0_transpose_item(a.in[26], PLE, D, nullptr, (bf16*)(ws + W_PP1), 0, scr, r, lane); continue; } r -= I_PP;
        const int e = r / (2 * I_EG + I_ED); r -= e * (2 * I_EG + I_ED);
        if (r < I_EG) { p0_transpose_item(a.in[21] + (size_t)e * D * DFE, D, DFE, a.in[19], (bf16*)(ws + W_EGU) + (size_t)e * 2 * DFE * D, 1, scr, r, lane); continue; } r -= I_EG;
        if (r < I_EG) { p0_transpose_item(a.in[22] + (size_t)e * D * DFE, D, DFE, a.in[19], (bf16*)(ws + W_EGU) + (size_t)e * 2 * DFE * D, 2, scr, r, lane); continue; } r -= I_EG;
        p0_transpose_item(a.in[23] + (size_t)e * DFE * D, DFE, D, nullptr, (bf16*)(ws + W_ED) + (size_t)e * D * DFE, 0, scr, r, lane);
    }
    for (int m = gw; m < M; m += NGW) { const float s = row_to_bf16_ssq(a.in[0] + (size_t)m * D, (bf16*)(ws + WS_XBA) + (size_t)m * D, lane);
        if (lane == 0) *(GAS f32x4*)((float*)(ws + WS_SSQA) + 4 * (size_t)m) = (f32x4){s, 0.f, 0.f, 0.f}; }
    cvt_f32_bf16_flat(a.in[1], (bf16*)(ws + R_PB0), (size_t)M * PLE / 8, blockIdx.x * (NWAVES * 64) + tid, F.G * NWAVES * 64);
}

typedef short bf16x8_t __attribute__((ext_vector_type(8)));
typedef short s16x4_t __attribute__((ext_vector_type(4)));
typedef float f32x16 __attribute__((ext_vector_type(16)));
constexpr int KSTR = 272, VSTR = 320;
constexpr int KT_BYTES = 64 * KSTR, VT_BYTES = 64 * VSTR, KV_STAGE = KT_BYTES + VT_BYTES;
constexpr int ATT_LDS_PRE = 12288, ATT_LDS_KV = 16384;
constexpr int KSTR64 = 144, VSTR64 = 192;
__device__ __forceinline__ int crow16(int i, int h) { return (i & 3) + 8 * (i >> 2) + 4 * h; }
__device__ __forceinline__ int list_off(int j) { return 256 * (31 * j - (j * (j - 1)) / 2); }
__device__ __forceinline__ f32x16 mfma32(bf16x8_t a, bf16x8_t b, f32x16 c) { return __builtin_amdgcn_mfma_f32_32x32x16_bf16(a, b, c, 0, 0, 0); }
__device__ __forceinline__ s16x4_t vtr(const LAS unsigned char* p) { return __builtin_bit_cast(s16x4_t, __builtin_amdgcn_ds_read_tr16_b64_v4i16((LAS s16x4_t*)p)); }
struct KVRegs { v4u k0, k1, v0, v1; };
__device__ __forceinline__ void kv_load(KVRegs& r, const bf16* Kb, const bf16* Vb, size_t row0, int h, int tid) {
    const size_t off = (row0 + (tid >> 3)) * D + h * 128 + (tid & 7) * 8;
    r.k0 = *(const GAS v4u*)(Kb + off); r.k1 = *(const GAS v4u*)(Kb + off + 64); r.v0 = *(const GAS v4u*)(Vb + off); r.v1 = *(const GAS v4u*)(Vb + off + 64);
}
__device__ __forceinline__ void kv_store(const KVRegs& r, LAS unsigned char* stage, int tid) {
    LAS unsigned char* kp = stage + (tid >> 3) * KSTR + (tid & 7) * 16; LAS unsigned char* vp = stage + KT_BYTES + (tid >> 3) * VSTR + (tid & 7) * 16;
    *(LAS v4u*)kp = r.k0; *(LAS v4u*)(kp + 128) = r.k1; *(LAS v4u*)vp = r.v0; *(LAS v4u*)(vp + 128) = r.v1;
}
template <int NKS, int KS_> __device__ __forceinline__ void attn_qk(const LAS unsigned char* Kt, const bf16x8_t (&qf)[NKS], f32x16& p0, f32x16& p1, int lane) {
    const LAS unsigned char* kb = Kt + (lane & 31) * KS_ + (lane >> 5) * 16;
#pragma unroll
    for (int ks = 0; ks < NKS; ++ks) { const bf16x8_t a0 = *(const LAS bf16x8_t*)(kb + ks * 32), a1 = *(const LAS bf16x8_t*)(kb + 32 * KS_ + ks * 32);
        if (ks == 0) { f32x16 z; for (int i = 0; i < 16; ++i) z[i] = 0.f; p0 = mfma32(a0, qf[0], z); p1 = mfma32(a1, qf[0], z); }
        else { p0 = mfma32(a0, qf[ks], p0); p1 = mfma32(a1, qf[ks], p1); } }
}
template <int NDT, int VS_> __device__ __forceinline__ void attn_softmax_pv(const LAS unsigned char* Vt, f32x16& p0, f32x16& p1, f32x16 (&o)[NDT], float& m, float& l, int lane) {
    float mt = p0[0];
#pragma unroll
    for (int i = 1; i < 16; ++i) mt = fmaxf(mt, p0[i]);
#pragma unroll
    for (int i = 0; i < 16; ++i) mt = fmaxf(mt, p1[i]);
    mt = fmaxf(mt, __shfl_xor(mt, 32));
    if (__any(mt > m)) {
        const float mn = fmaxf(m, mt); const float alpha = __builtin_amdgcn_exp2f(m - (mn == -INFINITY ? 0.f : mn));
        l *= alpha; m = mn;
#pragma unroll
        for (int dt = 0; dt < NDT; ++dt)
#pragma unroll
            for (int i = 0; i < 16; ++i) o[dt][i] *= alpha;
    }
    const float ms = m == -INFINITY ? 0.f : m;
    float ls = 0.f;
#pragma unroll
    for (int i = 0; i < 16; ++i) { p0[i] = __builtin_amdgcn_exp2f(p0[i] - ms); ls += p0[i]; }
#pragma unroll
    for (int i = 0; i < 16; ++i) { p1[i] = __builtin_amdgcn_exp2f(p1[i] - ms); ls += p1[i]; }
    l += ls;
    bf16x8_t pb[4];
#pragma unroll
    for (int s = 0; s < 4; ++s) { v4u w;
        if (s < 2) { w.x = pk2(p0[8 * s + 0], p0[8 * s + 1]); w.y = pk2(p0[8 * s + 2], p0[8 * s + 3]); w.z = pk2(p0[8 * s + 4], p0[8 * s + 5]); w.w = pk2(p0[8 * s + 6], p0[8 * s + 7]); }
        else { const int t = s - 2; w.x = pk2(p1[8 * t + 0], p1[8 * t + 1]); w.y = pk2(p1[8 * t + 2], p1[8 * t + 3]); w.z = pk2(p1[8 * t + 4], p1[8 * t + 5]); w.w = pk2(p1[8 * t + 6], p1[8 * t + 7]); }
        pb[s] = __builtin_bit_cast(bf16x8_t, w); }
    const int i16 = lane & 15, q4 = i16 >> 2, p4 = i16 & 3, blk = (lane >> 4) & 1, hh = lane >> 5;
    const LAS unsigned char* vb = Vt + (4 * hh + q4) * VS_ + blk * 32 + p4 * 8;
#pragma unroll
    for (int dt = 0; dt < NDT; ++dt)
#pragma unroll
        for (int s = 0; s < 4; ++s) { const s16x4_t lo = vtr(vb + (16 * s) * VS_ + dt * 64), hi = vtr(vb + (16 * s + 8) * VS_ + dt * 64);
            const bf16x8_t vf = __builtin_shufflevector(lo, hi, 0, 1, 2, 3, 4, 5, 6, 7);
            o[dt] = mfma32(vf, pb[s], o[dt]); }
}

__device__ __forceinline__ void l0_mixer_naive(Frame& F, const Args& a) {
    int tid_ = threadIdx.x; asm volatile("" : "+v"(tid_)); const int tid = tid_, lane = tid & 63, wave = __builtin_amdgcn_readfirstlane(tid >> 6); (void)lane; (void)wave;
    const bf16* Z = (const bf16*)(F.ws + R_Z); bf16* MIX = (bf16*)(F.ws + R_MIX);
    const int gw = blockIdx.x * NWAVES + wave, NGW = F.G * NWAVES;
    {
        const float* cw = a.in[6];
        const int c0 = lane * 8;
        float w0[8], w1[8], w2[8];
#pragma unroll
        for (int j = 0; j < 8; ++j) { w0[j] = cw[c0 + j]; w1[j] = cw[512 + c0 + j]; w2[j] = cw[1024 + c0 + j]; }
        for (int tok = gw; tok < M; tok += NGW) {
            const int t = tok & (SEQ - 1);
            float acc[8];
#pragma unroll
            for (int j = 0; j < 8; ++j) acc[j] = 0.f;
#pragma unroll
            for (int dt = 0; dt < 3; ++dt) {
                if (t - dt >= 0) {
                    const bf16* zr = Z + (size_t)(tok - dt) * DIN0;
                    const v4u cc = *(const GAS v4u*)(zr + ZC_C + c0), uu = *(const GAS v4u*)(zr + ZC_U + c0);
                    const unsigned cw4[4] = {cc.x, cc.y, cc.z, cc.w}, uw4[4] = {uu.x, uu.y, uu.z, uu.w};
#pragma unroll
                    for (int q = 0; q < 4; ++q) { const float p0 = bflo(cw4[q]) * bflo(uw4[q]), p1 = bfhi(cw4[q]) * bfhi(uw4[q]);
                        const float wa = dt == 0 ? w2[2 * q] : (dt == 1 ? w1[2 * q] : w0[2 * q]), wb = dt == 0 ? w2[2 * q + 1] : (dt == 1 ? w1[2 * q + 1] : w0[2 * q + 1]);
                        acc[2 * q] += wa * p0; acc[2 * q + 1] += wb * p1; }
                }
            }
            const v4u bb = *(const GAS v4u*)(Z + (size_t)tok * DIN0 + ZC_B + c0);
            v4u o; o.x = pk2(bflo(bb.x) * acc[0], bfhi(bb.x) * acc[1]); o.y = pk2(bflo(bb.y) * acc[2], bfhi(bb.y) * acc[3]);
            o.z = pk2(bflo(bb.z) * acc[4], bfhi(bb.z) * acc[5]); o.w = pk2(bflo(bb.w) * acc[6], bfhi(bb.w) * acc[7]);
            *(GAS v4u*)(MIX + (size_t)tok * D + c0) = o;
        }
    }
    LAS float* tab = (LAS float*)F.lds;
    __syncthreads();
    fill_tab<0>(tab, a.in[2], tid);
    LAS unsigned char* Kl = F.lds + TAB_BYTES; LAS unsigned char* Vl = Kl + 256 * KSTR64;
    const int r32 = lane & 31, hh = lane >> 5;
    for (int u = blockIdx.x; u < 2 * 2 * 64; u += F.G) {
        const int qb = u & 63, kvh = (u >> 6) & 1, b = u >> 7;
        __syncthreads();
#pragma unroll
        for (int i = 0; i < 4; ++i) { const int c = tid + 512 * i, row = c >> 3, c16 = c & 7; int pos = 128 * (qb - 1) + row; pos = pos < 0 ? 0 : pos;
            const bf16* zr = Z + (size_t)(b * SEQ + pos) * DIN0 + kvh * 64 + c16 * 8;
            *(LAS v4u*)(Kl + row * KSTR64 + c16 * 16) = *(const GAS v4u*)(zr + ZC_K); *(LAS v4u*)(Vl + row * VSTR64 + c16 * 16) = *(const GAS v4u*)(zr + ZC_V); }
        __syncthreads();
        const int g = wave >> 1, qh = wave & 1, hd = kvh * 4 + g;
        const float sinkl = a.in[7][hd] * LOG2E;
#pragma unroll 1
        for (int sub = 0; sub < 2; ++sub) {
            const int qrel = 64 * qh + 32 * sub + r32;
            const int tok = b * SEQ + 128 * qb + qrel;
            bf16x8_t qf[4];
            { const GAS bf16x8_t* qp = (const GAS bf16x8_t*)(Z + (size_t)tok * DIN0 + ZC_Q + hd * 64 + 8 * hh);
#pragma unroll
              for (int ks = 0; ks < 4; ++ks) qf[ks] = qp[2 * ks]; }
            f32x16 o[2];
#pragma unroll
            for (int dt = 0; dt < 2; ++dt)
#pragma unroll
                for (int i = 0; i < 16; ++i) o[dt][i] = 0.f;
            float m = -INFINITY, l = 0.f;
#pragma unroll 1
            for (int kk = 0; kk < 3; ++kk) {
                const int kt = qh + kk;
                if (qb == 0 && kt < 2) continue;
                f32x16 p0, p1;
                attn_qk<4, KSTR64>(Kl + kt * 64 * KSTR64, qf, p0, p1, lane);
                bias_add(p0, p1, tab + hd * TABN + (319 - ((128 + qrel) - kt * 64 - 4 * hh)));
                attn_softmax_pv<2, VSTR64>(Vl + kt * 64 * VSTR64, p0, p1, o, m, l, lane);
            }
            l += __shfl_xor(l, 32);
            const float inv = 1.0f / (l + __builtin_amdgcn_exp2f(sinkl - m));
            bf16* mo = MIX + (size_t)tok * D + 512 + hd * 64 + 4 * hh;
#pragma unroll
            for (int dt = 0; dt < 2; ++dt)
#pragma unroll
                for (int gg = 0; gg < 4; ++gg) { v2u w; w.x = pk2(o[dt][4 * gg] * inv, o[dt][4 * gg + 1] * inv); w.y = pk2(o[dt][4 * gg + 2] * inv, o[dt][4 * gg + 3] * inv); *(GAS v2u*)(mo + 32 * dt + 8 * gg) = w; }
        }
    }
}

__device__ __forceinline__ void l1_kmean(Frame& F) {
    int tid_ = threadIdx.x; asm volatile("" : "+v"(tid_)); const int tid = tid_, lane = tid & 63, wave = __builtin_amdgcn_readfirstlane(tid >> 6); (void)lane; (void)wave;
    const bf16* Kb = (const bf16*)(F.ws + R_K); float* KM = (float*)(F.ws + WS_KM);
    LAS float* red = (LAS float*)F.lds;
    for (int task = blockIdx.x; task < 2 * 32 * 8; task += F.G) {
        const int h = task & 7, bn = task >> 3;
        const bf16* base = Kb + (size_t)(bn * 256 + wave * 32) * D + h * 128 + 2 * lane;
        float s0 = 0.f, s1 = 0.f;
        for (int r = 0; r < 32; ++r) { const unsigned w = *(const GAS unsigned*)(base + (size_t)r * D); s0 += bflo(w); s1 += bfhi(w); }
        red[wave * 128 + 2 * lane] = s0; red[wave * 128 + 2 * lane + 1] = s1;
        __syncthreads();
        if (tid < 128) { float s = 0.f;
#pragma unroll
            for (int w = 0; w < 8; ++w) s += red[w * 128 + tid];
            KM[(size_t)bn * D + h * 128 + tid] = s * (1.0f / 256.0f); }
        __syncthreads();
    }
}
__device__ __forceinline__ void l1_moba_select(Frame& F) {
    int tid_ = threadIdx.x; asm volatile("" : "+v"(tid_)); const int tid = tid_, lane = tid & 63, wave = __builtin_amdgcn_readfirstlane(tid >> 6); (void)lane; (void)wave;
    const bf16* Qb = (const bf16*)(F.ws + R_Q); const float* KM = (const float*)(F.ws + WS_KM);
    unsigned* lcnt = (unsigned*)(F.ctl + CW_LCNT); int* lists = (int*)(F.ws + R_LIST);
    LAS float* kmL = (LAS float*)F.lds;
    for (int chunk = blockIdx.x; chunk < 256; chunk += F.G) {
        const int bh = chunk >> 4, g = chunk & 15, b = bh >> 3, h = bh & 7;
        __syncthreads();
        for (int i = tid; i < 4096; i += NWAVES * 64) kmL[i] = KM[(size_t)(b * 32 + (i >> 7)) * D + h * 128 + (i & 127)];
        __syncthreads();
        const int t = g * 512 + wave * 64 + lane, qblk = (g * 512 + wave * 64) >> 8;
        if (qblk == 0) continue;
        float acc[31];
#pragma unroll
        for (int n = 0; n < 31; ++n) acc[n] = 0.f;
        const GAS v4u* qr = (const GAS v4u*)(Qb + (size_t)(b * SEQ + t) * D + h * 128);
#pragma unroll 1
        for (int c = 0; c < 16; ++c) { const v4u w = qr[c];
            const float q0 = bflo(w.x), q1 = bfhi(w.x), q2 = bflo(w.y), q3 = bfhi(w.y), q4 = bflo(w.z), q5 = bfhi(w.z), q6 = bflo(w.w), q7 = bfhi(w.w);
#pragma unroll
            for (int n = 0; n < 31; ++n) if (n < qblk) { const f32x4 ka = *(const LAS f32x4*)(kmL + n * 128 + c * 8), kb = *(const LAS f32x4*)(kmL + n * 128 + c * 8 + 4);
                acc[n] += (q0 * ka.x + q1 * ka.y) + (q2 * ka.z + q3 * ka.w) + (q4 * kb.x + q5 * kb.y) + (q6 * kb.z + q7 * kb.w); } }
        float v1 = -INFINITY, v2 = -INFINITY, v3 = -INFINITY; int i1 = -1, i2 = -1, i3 = -1;
#pragma unroll
        for (int n = 0; n < 31; ++n) if (n < qblk) { const float v = acc[n];
            if (v > v1) { v3 = v2; i3 = i2; v2 = v1; i2 = i1; v1 = v; i1 = n; } else if (v > v2) { v3 = v2; i3 = i2; v2 = v; i2 = n; } else if (v > v3) { v3 = v; i3 = n; } }
        for (int j = 0; j < qblk; ++j) {
            const bool hit = (i1 == j) | (i2 == j) | (i3 == j);
            const unsigned long long mk = __ballot(hit);
            if (mk == 0ull) continue;
            const int cntj = __popcll(mk);
            unsigned base = 0;
            if (lane == 0) base = __hip_atomic_fetch_add(lcnt + bh * 32 + j, (unsigned)cntj, __ATOMIC_RELAXED, __HIP_MEMORY_SCOPE_AGENT);
            base = __builtin_amdgcn_readfirstlane(base);
            if (hit) { const int off = __popcll(mk & ((1ull << lane) - 1ull)); const int rk = (i1 == j) ? 0 : ((i2 == j) ? 1 : 2);
                const unsigned idx = base + off;
                if (idx < (unsigned)(256 * (31 - j))) lists[(size_t)bh * 126976 + list_off(j) + idx] = t | (rk << 13); }
        }
    }
}
__device__ __forceinline__ void l1_moba_partial(Frame& F, const Args& a) {
    int tid_ = threadIdx.x; asm volatile("" : "+v"(tid_)); const int tid = tid_, lane = tid & 63, wave = __builtin_amdgcn_readfirstlane(tid >> 6); (void)lane; (void)wave;
    const bf16* Qb = (const bf16*)(F.ws + R_Q); const bf16* Kb = (const bf16*)(F.ws + R_K); const bf16* Vb = (const bf16*)(F.ws + R_V);
    bf16* PO = (bf16*)(F.ws + R_PO); float* ML = (float*)(F.ws + R_ML);
    const unsigned* lcnt = (const unsigned*)(F.ctl + CW_LCNT); const int* lists = (const int*)(F.ws + R_LIST);
    const int r32 = lane & 31, hh = lane >> 5;
    LAS float* tab = (LAS float*)F.lds; LAS int* pre = (LAS int*)(F.lds + ATT_LDS_PRE);
    fill_tab<2>(tab, a.in[2], tid);
    {
        const int li = tid; const int jj = li & 31; unsigned c = lcnt[li]; const unsigned cap = 256u * (31 - jj); c = c > cap ? cap : c;
        const int tiles = (int)((c + 255u) >> 8);
        int x = tiles;
#pragma unroll
        for (int o = 1; o < 64; o <<= 1) { const int y = __shfl_up(x, o); if (lane >= o) x += y; }
        LAS int* wt = pre + 520;
        if (lane == 63) wt[wave] = x;
        __syncthreads();
        int wo = 0;
#pragma unroll
        for (int w = 0; w < 8; ++w) if (w < wave) wo += wt[w];
        pre[li + 1] = wo + x; if (li == 0) pre[0] = 0;
        __syncthreads();
    }
    const int total = pre[512];
    LAS unsigned char* kv = F.lds + ATT_LDS_KV;
    for (int u = blockIdx.x; u < total; u += F.G) {
        int lo = 0, hi = 511;
        while (lo < hi) { const int mid = (lo + hi + 1) >> 1; if (pre[mid] <= u) lo = mid; else hi = mid - 1; }
        const int li = lo, tile = u - pre[li], bh = li >> 5, j = li & 31, b = bh >> 3, h = bh & 7;
        unsigned nl = lcnt[li]; { const unsigned cap = 256u * (31 - j); nl = nl > cap ? cap : nl; }
        const int ridx = tile * 256 + wave * 32 + r32; const bool rvalid = ridx < (int)nl;
        const int ent = lists[(size_t)bh * 126976 + list_off(j) + (rvalid ? ridx : 0)];
        const int t = ent & 8191, rk = ent >> 13;
        bf16x8_t qf[8];
        { const GAS bf16x8_t* qp = (const GAS bf16x8_t*)(Qb + (size_t)(b * SEQ + t) * D + h * 128 + 8 * hh);
#pragma unroll
          for (int ks = 0; ks < 8; ++ks) qf[ks] = qp[2 * ks]; }
        const bool near = t < j * 256 + 382;
        const bool anynear = __any(near);
        f32x16 o[4];
#pragma unroll
        for (int dt = 0; dt < 4; ++dt)
#pragma unroll
            for (int i = 0; i < 16; ++i) o[dt][i] = 0.f;
        float m = -INFINITY, l = 0.f;
        const size_t krow0 = (size_t)b * SEQ + j * 256;
        KVRegs kr;
        __syncthreads();
        kv_load(kr, Kb, Vb, krow0, h, tid); kv_store(kr, kv, tid);
        __syncthreads();
#pragma unroll 1
        for (int kt = 0; kt < 4; ++kt) {
            if (kt < 3) kv_load(kr, Kb, Vb, krow0 + (kt + 1) * 64, h, tid);
            const LAS unsigned char* st = kv + (kt & 1) * KV_STAGE;
            f32x16 p0, p1;
            attn_qk<8, KSTR>(st, qf, p0, p1, lane);
            if (anynear && kt >= 2) { int bq = t - (j * 256 + kt * 64) - 4 * hh; bq = bq > 319 ? 319 : bq; bias_add(p0, p1, tab + h * TABN + (319 - bq)); }
            attn_softmax_pv<4, VSTR>(st + KT_BYTES, p0, p1, o, m, l, lane);
            if (kt < 3) kv_store(kr, kv + ((kt + 1) & 1) * KV_STAGE, tid);
            __syncthreads();
        }
        l += __shfl_xor(l, 32);
        if (rvalid) {
            const size_t pidx = ((size_t)((rk * 2 + b) * 8 + h) * SEQ + t);
            if (hh == 0) *(GAS pg8::f32x2*)(ML + pidx * 2) = (pg8::f32x2){m, l};
            bf16* po = PO + pidx * 128 + 4 * hh;
#pragma unroll
            for (int dt = 0; dt < 4; ++dt)
#pragma unroll
                for (int g = 0; g < 4; ++g) { v2u w; w.x = pk2(o[dt][4 * g], o[dt][4 * g + 1]); w.y = pk2(o[dt][4 * g + 2], o[dt][4 * g + 3]); *(GAS v2u*)(po + 32 * dt + 8 * g) = w; }
        }
    }
}
__device__ __forceinline__ void l1_moba_own_merge(Frame& F, const Args& a) {
    int tid_ = threadIdx.x; asm volatile("" : "+v"(tid_)); const int tid = tid_, lane = tid & 63, wave = __builtin_amdgcn_readfirstlane(tid >> 6); (void)lane; (void)wave;
    const bf16* Qb = (const bf16*)(F.ws + R_Q); const bf16* Kb = (const bf16*)(F.ws + R_K); const bf16* Vb = (const bf16*)(F.ws + R_V);
    const bf16* PO = (const bf16*)(F.ws + R_PO); const float* ML = (const float*)(F.ws + R_ML); bf16* ATT = (bf16*)(F.ws + R_ATT);
    const int r32 = lane & 31, hh = lane >> 5;
    LAS float* tab = (LAS float*)F.lds;
    __syncthreads();
    fill_tab<1>(tab, a.in[2], tid);
    __syncthreads();
    LAS unsigned char* kv = F.lds + ATT_LDS_KV;
    for (int u = blockIdx.x; u < 512; u += F.G) {
        const int bh = u >> 5, ib = u & 31, b = bh >> 3, h = bh & 7;
        const int qrel = wave * 32 + r32, t = ib * 256 + qrel;
        bf16x8_t qf[8];
        { const GAS bf16x8_t* qp = (const GAS bf16x8_t*)(Qb + (size_t)(b * SEQ + t) * D + h * 128 + 8 * hh);
#pragma unroll
          for (int ks = 0; ks < 8; ++ks) qf[ks] = qp[2 * ks]; }
        f32x16 o[4];
#pragma unroll
        for (int dt = 0; dt < 4; ++dt)
#pragma unroll
            for (int i = 0; i < 16; ++i) o[dt][i] = 0.f;
        float m = -INFINITY, l = 0.f;
        const size_t krow0 = (size_t)b * SEQ + ib * 256;
        KVRegs kr;
        __syncthreads();
        kv_load(kr, Kb, Vb, krow0, h, tid); kv_store(kr, kv, tid);
        __syncthreads();
#pragma unroll 1
        for (int kt = 0; kt < 4; ++kt) {
            if (kt < 3) kv_load(kr, Kb, Vb, krow0 + (kt + 1) * 64, h, tid);
            const LAS unsigned char* st = kv + (kt & 1) * KV_STAGE;
            if (kt * 64 <= wave * 32 + 31) {
                f32x16 p0, p1;
                attn_qk<8, KSTR>(st, qf, p0, p1, lane);
                bias_add(p0, p1, tab + h * TABN + (319 - (qrel - kt * 64 - 4 * hh)));
                attn_softmax_pv<4, VSTR>(st + KT_BYTES, p0, p1, o, m, l, lane);
            }
            if (kt < 3) kv_store(kr, kv + ((kt + 1) & 1) * KV_STAGE, tid);
            __syncthreads();
        }
        l += __shfl_xor(l, 32);
        const int nsel = ib < 3 ? ib : 3;
        const float c31 = tab[h * TABN + 192];
        float mr[3], lr[3]; float mx = m;
#pragma unroll
        for (int r = 0; r < 3; ++r) { mr[r] = -INFINITY; lr[r] = 0.f;
            if (r < nsel) { const size_t pidx = ((size_t)((r * 2 + b) * 8 + h) * SEQ + t); const pg8::f32x2 v = *(const GAS pg8::f32x2*)(ML + pidx * 2); mr[r] = v[0] + c31; lr[r] = v[1]; mx = fmaxf(mx, mr[r]); } }
        const float f0 = __builtin_amdgcn_exp2f(m - mx);
        float lt = l * f0;
#pragma unroll
        for (int dt = 0; dt < 4; ++dt)
#pragma unroll
            for (int i = 0; i < 16; ++i) o[dt][i] *= f0;
#pragma unroll
        for (int r = 0; r < 3; ++r) if (r < nsel) { const float fr = __builtin_amdgcn_exp2f(mr[r] - mx); lt += lr[r] * fr;
            const bf16* po = PO + ((size_t)((r * 2 + b) * 8 + h) * SEQ + t) * 128 + 4 * hh;
#pragma unroll
            for (int dt = 0; dt < 4; ++dt)
#pragma unroll
                for (int g = 0; g < 4; ++g) { const v2u w = *(const GAS v2u*)(po + 32 * dt + 8 * g);
                    o[dt][4 * g] += fr * bflo(w.x); o[dt][4 * g + 1] += fr * bfhi(w.x); o[dt][4 * g + 2] += fr * bflo(w.y); o[dt][4 * g + 3] += fr * bfhi(w.y); } }
        const float inv = 1.0f / lt;
        bf16* ao = ATT + (size_t)(b * SEQ + t) * D + h * 128 + 4 * hh;
#pragma unroll
        for (int dt = 0; dt < 4; ++dt)
#pragma unroll
            for (int g = 0; g < 4; ++g) { v2u w; w.x = pk2(o[dt][4 * g] * inv, o[dt][4 * g + 1] * inv); w.y = pk2(o[dt][4 * g + 2] * inv, o[dt][4 * g + 3] * inv); *(GAS v2u*)(ao + 32 * dt + 8 * g) = w; }
    }
}

__device__ __forceinline__ void l1_route(Frame& F, const Args& a) {
    int tid_ = threadIdx.x; asm volatile("" : "+v"(tid_)); const int tid = tid_, lane = tid & 63, wave = __builtin_amdgcn_readfirstlane(tid >> 6); (void)lane; (void)wave;
    LAS float* WrL = (LAS float*)F.lds;
    LAS int* lcnt = (LAS int*)(F.lds + 32768);
    LAS int* lbase = lcnt + 8;
    LAS int* tiE = lcnt + 16;
    LAS int* tiL = tiE + 128;
    LAS float* tiW = (LAS float*)(tiL + 128);
    LAS float* tiR = tiW + 128;
    const float* router = a.in[20]; const float* gain = a.in[19];
    for (int i = tid; i < 8192; i += NWAVES * 64) WrL[i] = router[i] * gain[i >> 3];
    unsigned* gcnt = (unsigned*)(F.ctl + CW_ECNT);
    int* tok_e = (int*)(F.ws + WS_TOKE); float* gw_e = (float*)(F.ws + WS_GWE); float* rs_e = (float*)(F.ws + WS_RSE); int* pos = (int*)(F.ws + WS_POS);
    for (int chunk = blockIdx.x; chunk < M / 64; chunk += F.G) {
        if (tid < 8) lcnt[tid] = 0;
        __syncthreads();
        for (int tt = wave; tt < 64; tt += NWAVES) {
            const int tok = chunk * 64 + tt;
            const GAS v4u* hr = (const GAS v4u*)((const bf16*)(F.ws + WS_XBA) + (size_t)tok * D) + lane;
            float lg[8]; float ss = 0.f;
#pragma unroll
            for (int e = 0; e < 8; ++e) lg[e] = 0.f;
#pragma unroll
            for (int j = 0; j < 2; ++j) { const v4u hw = hr[64 * j]; const float hx[8] = {bflo(hw.x), bfhi(hw.x), bflo(hw.y), bfhi(hw.y), bflo(hw.z), bfhi(hw.z), bflo(hw.w), bfhi(hw.w)};
#pragma unroll
                for (int q = 0; q < 8; ++q) { const int k = j * 512 + lane * 8 + q; const f32x4 wa = *(const LAS f32x4*)(WrL + k * 8), wb = *(const LAS f32x4*)(WrL + k * 8 + 4);
                    ss += hx[q] * hx[q];
                    lg[0] += hx[q] * wa.x; lg[1] += hx[q] * wa.y; lg[2] += hx[q] * wa.z; lg[3] += hx[q] * wa.w; lg[4] += hx[q] * wb.x; lg[5] += hx[q] * wb.y; lg[6] += hx[q] * wb.z; lg[7] += hx[q] * wb.w; } }
            ss = wave_sum(ss);
#pragma unroll
            for (int e = 0; e < 8; ++e) lg[e] = wave_sum(lg[e]);
            const float rs = rsqrtf(ss * (1.0f / 1024.0f) + EPS);
            float v0 = lg[0]; int e0 = 0;
#pragma unroll
            for (int e = 1; e < 8; ++e) if (lg[e] > v0) { v0 = lg[e]; e0 = e; }
            float v1 = -INFINITY; int e1 = 0;
#pragma unroll
            for (int e = 0; e < 8; ++e) if (e != e0 && lg[e] > v1) { v1 = lg[e]; e1 = e; }
            const float w0 = 1.0f / (1.0f + __expf((v1 - v0) * rs)), w1 = 1.0f - w0;
            if (lane == 0) { const int l0 = __hip_atomic_fetch_add(&lcnt[e0], 1, __ATOMIC_RELAXED, __HIP_MEMORY_SCOPE_WORKGROUP), l1 = __hip_atomic_fetch_add(&lcnt[e1], 1, __ATOMIC_RELAXED, __HIP_MEMORY_SCOPE_WORKGROUP);
                tiE[2 * tt] = e0; tiE[2 * tt + 1] = e1; tiL[2 * tt] = l0; tiL[2 * tt + 1] = l1; tiW[2 * tt] = w0; tiW[2 * tt + 1] = w1; tiR[tt] = rs; }
        }
        __syncthreads();
        if (tid < 8) lbase[tid] = (int)__hip_atomic_fetch_add(gcnt + tid, (unsigned)lcnt[tid], __ATOMIC_RELAXED, __HIP_MEMORY_SCOPE_AGENT);
        __syncthreads();
        if (tid < 128) { const int tt = tid >> 1, e = tiE[tid], idx = lbase[e] + tiL[tid], tok = chunk * 64 + tt;
            if (idx < 16384) { tok_e[e * 16384 + idx] = tok; gw_e[e * 16384 + idx] = tiW[tid]; rs_e[e * 16384 + idx] = tiR[tt]; }
            pos[2 * tok + (tid & 1)] = (e << 16) | idx; }
        __syncthreads();
    }
}
__device__ __forceinline__ void l1_combine(Frame& F, const Args& a) {
    int tid_ = threadIdx.x; asm volatile("" : "+v"(tid_)); const int tid = tid_, lane = tid & 63, wave = __builtin_amdgcn_readfirstlane(tid >> 6); (void)lane; (void)wave;
    const int gw = blockIdx.x * NWAVES + wave, NGW = F.G * NWAVES;
    const int* cntp = (const int*)(F.ctl + CW_ECNT); const int* pos = (const int*)(F.ws + WS_POS);
    pg8::MoeTiles T; T.init(cntp);
    int main_tiles; { int nl = T.t8 - 128; nl = nl < 0 ? 0 : (nl > MOE_SUB_TILES ? MOE_SUB_TILES : nl); main_tiles = T.t8 - nl; }
    const float* YP = (const float*)(F.ws + R_YP);
    const bf16* Y = (const bf16*)(F.ws + R_Y); const bf16* XI = (const bf16*)(F.ws + WS_XBA); bf16* XO = (bf16*)(F.ws + R_XBB); float* ssq = (float*)(F.ws + WS_SSQA);
    for (int tok = gw; tok < M; tok += NGW) {
        const int p0 = pos[2 * tok], p1 = pos[2 * tok + 1];
        const int b0 = T.base_of(p0 >> 16), b1 = T.base_of(p1 >> 16);
        const size_t r0 = (size_t)b0 * 256 + (p0 & 0xffff), r1 = (size_t)b1 * 256 + (p1 & 0xffff);
        const bool sub0 = (int)(r0 >> 8) >= main_tiles, sub1 = (int)(r1 >> 8) >= main_tiles;
        float s = 0.f;
#pragma unroll
        for (int j = 0; j < 2; ++j) {
            const int col = j * 512 + lane * 8;
            const v4u hw = *(const GAS v4u*)(XI + (size_t)tok * D + col);
            float h[8] = {bflo(hw.x), bfhi(hw.x), bflo(hw.y), bfhi(hw.y), bflo(hw.z), bfhi(hw.z), bflo(hw.w), bfhi(hw.w)};
#pragma unroll
            for (int sl = 0; sl < 2; ++sl) { const size_t r = sl == 0 ? r0 : r1; const bool sub = sl == 0 ? sub0 : sub1;
                if (sub) { const GAS f32x4* yp = (const GAS f32x4*)(YP + (r - (size_t)main_tiles * 256) * D + col);
#pragma unroll
                    for (int kc = 0; kc < MOE_NKC; ++kc) { const f32x4 a0 = yp[(size_t)kc * MOE_SUB_TILES * 256 * D / 4], a1 = yp[(size_t)kc * MOE_SUB_TILES * 256 * D / 4 + 1];
                        h[0] += a0.x; h[1] += a0.y; h[2] += a0.z; h[3] += a0.w; h[4] += a1.x; h[5] += a1.y; h[6] += a1.z; h[7] += a1.w; } }
                else { const v4u yw = *(const GAS v4u*)(Y + r * D + col);
                    h[0] += bflo(yw.x); h[1] += bfhi(yw.x); h[2] += bflo(yw.y); h[3] += bfhi(yw.y); h[4] += bflo(yw.z); h[5] += bfhi(yw.z); h[6] += bflo(yw.w); h[7] += bfhi(yw.w); } }
            v4u w; w.x = pk2(h[0], h[1]); w.y = pk2(h[2], h[3]); w.z = pk2(h[4], h[5]); w.w = pk2(h[6], h[7]);
            *(GAS v4u*)(XO + (size_t)tok * D + col) = w;
#pragma unroll
            for (int q = 0; q < 8; ++q) s += h[q] * h[q];
        }
        s = wave_sum(s);
        if (lane == 0) *(GAS f32x4*)(ssq + 4 * (size_t)tok) = (f32x4){s, 0.f, 0.f, 0.f};
    }
    cvt_f32_bf16_flat(a.in[1] + (size_t)M * PLE, (bf16*)(F.ws + R_PB1), (size_t)M * PLE / 8, blockIdx.x * (NWAVES * 64) + tid, F.G * NWAVES * 64);
}
__device__ __forceinline__ void final_norm(Frame& F, const Args& a) {
    int tid_ = threadIdx.x; asm volatile("" : "+v"(tid_)); const int tid = tid_, lane = tid & 63, wave = __builtin_amdgcn_readfirstlane(tid >> 6); (void)lane; (void)wave;
    const int gw = blockIdx.x * NWAVES + wave, NGW = F.G * NWAVES;
    const float* ssq = (const float*)(F.ws + WS_SSQB); const float* g = a.in[3];
    f32x4 gv[4];
#pragma unroll
    for (int j = 0; j < 4; ++j) gv[j] = ((const GAS f32x4*)g)[64 * j + lane];
    for (int tok = gw; tok < M; tok += NGW) {
        const float rs = pg8::rstd_of(ssq, tok);
        GAS f32x4* hr = (GAS f32x4*)(F.H + (size_t)tok * D) + lane;
#pragma unroll
        for (int j = 0; j < 4; ++j) { f32x4 h = hr[64 * j]; h = h * rs * gv[j]; hr[64 * j] = h; }
    }
}

constexpr int N_PHASES = 19;
__global__ void __launch_bounds__(NWAVES * 64, 2) trunk_fwd(Args args) {
    extern __shared__ __attribute__((aligned(16))) unsigned char lds[];
    Frame F;
    F.lds = (LAS unsigned char*)lds;
    F.MISC = (volatile LAS unsigned*)(F.lds + MISC_OFF);
    F.G = gridDim.x;
    F.ws = args.ws; F.ctl = (gu32*)(args.ws + WS_CTL); F.H = args.out;
    unsigned char* ws = args.ws;
    for (int u = threadIdx.x; u < (LDS_BYTES - LDSCTL_OFF) / 4; u += NWAVES * 64) ((LAS unsigned*)(F.lds + LDSCTL_OFF))[u] = 0u;
    __syncthreads();
    XcdBarrier bar; bar.bar = (unsigned*)(F.ctl + CW_BAR); bar.x = 0; bar.st = nullptr;
    const int lo = args.ph_lo, hi = args.ph_hi;
    if (hi - lo > 1) bar = xcd_barrier_post((unsigned*)(F.ctl + CW_BAR), F.MISC + 8);
#define IN(k) (lo <= (k) && (k) < hi)
#define SEAM(k) do { if (IN(k) && IN((k) + 1)) xcd_barrier(bar); } while (0)
    const int bx = (int)blockIdx.x;
    float* SSQA = (float*)(ws + WS_SSQA); float* SSQB = (float*)(ws + WS_SSQB);
    bf16* XBA = (bf16*)(ws + WS_XBA); bf16* XBB = (bf16*)(ws + R_XBB); bf16* XBC = (bf16*)(ws + R_XBC);

    if (IN(0)) { p0_prologue(F, args); } SEAM(0);
    if (IN(1)) { pg8::Gemm g{XBA, (const bf16*)(ws + W_IN), D, 0, D}; pg8::StaticOrder S; S.init(M, DIN0, F.G, bx);
        pg8::EpiScaleBf16 E{(bf16*)(ws + R_Z), DIN0, SSQA, 0, 0, ZC_Q / 256, ZC_K / 256, SWA_C2};
        pg8::gemm_phase<pg8::EpiScaleBf16, pg8::StaticOrder, true, true, false>(F.lds, g, S, E); } SEAM(1);
    if (IN(2)) { l0_mixer_naive(F, args); } SEAM(2);
    if (IN(3)) { pg8::Gemm g{(const bf16*)(ws + R_MIX), (const bf16*)(ws + W_OUT), D, 0, D}; pg8::StaticOrder S; S.init(M, D, F.G, bx);
        pg8::EpiRes<false> E{XBA, XBB, nullptr, SSQB, nullptr, nullptr};
        pg8::gemm_phase<pg8::EpiRes<false>, pg8::StaticOrder, false, true, false>(F.lds, g, S, E); } SEAM(3);
    if (IN(4)) { pg8::Gemm g{XBB, (const bf16*)(ws + W_GU0), D, 0, D}; pg8::StaticOrder S; S.init(M, 2 * DFF0, F.G, bx);
        pg8::EpiSwiGLU<false> E{(bf16*)(ws + R_HM0), DFF0, SSQB};
        pg8::gemm_phase<pg8::EpiSwiGLU<false>, pg8::StaticOrder, true, true, false>(F.lds, g, S, E); } SEAM(4);
    if (IN(5)) { pg8::Gemm g{(const bf16*)(ws + R_HM0), (const bf16*)(ws + W_D0), DFF0, 0, DFF0}; pg8::StaticOrder S; S.init(M, D, F.G, bx);
        pg8::EpiRes<false> E{XBB, XBA, nullptr, SSQA, nullptr, nullptr};
        pg8::gemm_phase<pg8::EpiRes<false>, pg8::StaticOrder, false, true, false>(F.lds, g, S, E); } SEAM(5);
    if (IN(6)) {
        { pg8::Gemm g{(const bf16*)(ws + R_PB0), (const bf16*)(ws + W_PP0), PLE, 0, PLE}; pg8::StaticOrder S; S.init(M, D, F.G, bx);
          pg8::EpiPP E{(bf16*)(ws + R_PP)};
          pg8::gemm_phase<pg8::EpiPP, pg8::StaticOrder, false, true, false>(F.lds, g, S, E); }
        { pg8::Gemm g{XBA, (const bf16*)(ws + W_PG0), D, 0, D}; pg8::StaticOrder S; S.init(M, D, F.G, bx);
          pg8::EpiRes<true> E{XBA, XBC, nullptr, SSQB, SSQA, (const bf16*)(ws + R_PP)};
          pg8::gemm_phase<pg8::EpiRes<true>, pg8::StaticOrder, false, true, false>(F.lds, g, S, E); }
    } SEAM(6);
    if (IN(7)) { pg8::Gemm g{XBC, (const bf16*)(ws + W_QKV), D, 0, D}; pg8::StaticOrder S; S.init(M, 3 * D, F.G, bx);
        pg8::EpiScaleBf16 E{(bf16*)(ws + R_Q), D, SSQB, D, (size_t)(R_K - R_Q) / 2, 0, 4, MOBA_C2};
        pg8::gemm_phase<pg8::EpiScaleBf16, pg8::StaticOrder, true, true, false>(F.lds, g, S, E); } SEAM(7);
    if (IN(8)) { l1_kmean(F); } SEAM(8);
    if (IN(9)) { l1_moba_select(F); } SEAM(9);
    if (IN(10)) { l1_moba_partial(F, args); } SEAM(10);
    if (IN(11)) { l1_moba_own_merge(F, args); } SEAM(11);
    if (IN(12)) { pg8::Gemm g{(const bf16*)(ws + R_ATT), (const bf16*)(ws + W_O), D, 0, D}; pg8::StaticOrder S; S.init(M, D, F.G, bx);
        pg8::EpiRes<false> E{XBC, XBA, nullptr, nullptr, nullptr, nullptr};
        pg8::gemm_phase<pg8::EpiRes<false>, pg8::StaticOrder, false, true, false>(F.lds, g, S, E); } SEAM(12);
    if (IN(13)) { l1_route(F, args); } SEAM(13);
    if (IN(14)) { pg8::Gemm g{XBA, (const bf16*)(ws + W_EGU), D, (size_t)2 * DFE * D, D}; pg8::MoeOrder S; S.init((const int*)(F.ctl + CW_ECNT), 2 * DFE / 256, F.G, bx, (const int*)(ws + WS_TOKE), 0);
        pg8::EpiSwiGLU<true> E{(bf16*)(ws + R_HMG), DFE, (const float*)(ws + WS_RSE)};
        pg8::gemm_phase<pg8::EpiSwiGLU<true>, pg8::MoeOrder, true, true, true>(F.lds, g, S, E); } SEAM(14);
    if (IN(15)) {
        { pg8::Gemm g{(const bf16*)(ws + R_HMG), (const bf16*)(ws + W_ED), DFE, (size_t)D * DFE, DFE}; pg8::MoeOrder S; S.init((const int*)(F.ctl + CW_ECNT), D / 256, F.G, bx, nullptr, MOE_SUB_TILES);
          pg8::EpiMoeDown E{(bf16*)(ws + R_Y), (const float*)(ws + WS_GWE)};
          pg8::gemm_phase<pg8::EpiMoeDown, pg8::MoeOrder, true, true, false>(F.lds, g, S, E); }
        { pg8::Gemm g{(const bf16*)(ws + R_HMG), (const bf16*)(ws + W_ED), DFE / MOE_NKC, (size_t)D * DFE, DFE}; pg8::MoeSubOrder S; S.init((const int*)(F.ctl + CW_ECNT), D / 256, F.G, bx, MOE_SUB_TILES, MOE_NKC);
          pg8::EpiMoePartial E{(float*)(ws + R_YP), (const float*)(ws + WS_GWE), S.O.nM, (size_t)MOE_SUB_TILES * 256 * D};
          pg8::gemm_phase<pg8::EpiMoePartial, pg8::MoeSubOrder, true, true, false>(F.lds, g, S, E); }
    } SEAM(15);
    if (IN(16)) { l1_combine(F, args); } SEAM(16);
    if (IN(17)) {
        { pg8::Gemm g{(const bf16*)(ws + R_PB1), (const bf16*)(ws + W_PP1), PLE, 0, PLE}; pg8::StaticOrder S; S.init(M, D, F.G, bx);
          pg8::EpiPP E{(bf16*)(ws + R_PP1)};
          pg8::gemm_phase<pg8::EpiPP, pg8::StaticOrder, false, true, false>(F.lds, g, S, E); }
        { pg8::Gemm g{XBB, (const bf16*)(ws + W_PG1), D, 0, D}; pg8::StaticOrder S; S.init(M, D, F.G, bx);
          pg8::EpiRes<true> E{XBB, nullptr, F.H, SSQB, SSQA, (const bf16*)(ws + R_PP1)};
          pg8::gemm_phase<pg8::EpiRes<true>, pg8::StaticOrder, false, true, false>(F.lds, g, S, E); }
    } SEAM(17);
    if (IN(18)) { final_norm(F, args); }
#undef IN
#undef SEAM
}

extern "C" void kernel_launch(void* const* d_in, const int* in_sizes, int n_in, void* d_out, int out_size, void* d_ws, size_t ws_size, hipStream_t stream) {
    static int grid = 0;
    if (grid == 0) {
        if (n_in != 27 || in_sizes[0] != M * D || out_size != M * D || ws_size < WS_END) { fprintf(stderr, "kernel_launch: unexpected problem (n_in %d, in0 %d, out %d, ws %zu < %zu); nothing launched\n", n_in, n_in > 0 ? in_sizes[0] : -1, out_size, ws_size, (size_t)WS_END); grid = -1; return; }
        int dev = 0, cus = 0, per_cu = 0;
        if (hipGetDevice(&dev) != hipSuccess || hipDeviceGetAttribute(&cus, hipDeviceAttributeMultiprocessorCount, dev) != hipSuccess) { grid = -1; return; }
        if (hipFuncSetAttribute((const void*)trunk_fwd, hipFuncAttributeMaxDynamicSharedMemorySize, LDS_BYTES) != hipSuccess) { fprintf(stderr, "kernel_launch: hipFuncSetAttribute failed\n"); grid = -1; return; }
        if (hipOccupancyMaxActiveBlocksPerMultiprocessor(&per_cu, (const void*)trunk_fwd, NWAVES * 64, LDS_BYTES) != hipSuccess || per_cu < 1) fprintf(stderr, "kernel_launch: occupancy query reports %d\n", per_cu);
        (void)hipGetLastError();
        grid = cus;
        if (grid != 256) { fprintf(stderr, "kernel_launch: built for 256 CUs, found %d; nothing launched\n", cus); grid = -1; return; }
    }
    if (grid < 0) return;
    if (hipMemsetAsync((char*)d_ws + WS_CTL, 0, CTL_ZERO_BYTES, stream) != hipSuccess) return;
    Args a{};
    for (int i = 0; i < 27; ++i) a.in[i] = (const float*)d_in[i];
    a.out = (float*)d_out; a.ws = (unsigned char*)d_ws;
#if MK_ONE_LAUNCH
    a.ph_lo = 0; a.ph_hi = N_PHASES;
    hipLaunchKernelGGL(trunk_fwd, dim3(grid), dim3(NWAVES * 64), LDS_BYTES, stream, a);
#else
    for (int ph = 0; ph < N_PHASES; ++ph) for (int r = 0; r < (ph == PROBE_PHASE ? PROBE_CNT : 1); ++r) { a.ph_lo = ph; a.ph_hi = ph + 1; hipLaunchKernelGGL(trunk_fwd, dim3(grid), dim3(NWAVES * 64), LDS_BYTES, stream, a); }
#endif
}
```
